# Optimizing an MI355X kernel written in HIP

```python
import math
import jax, jax.numpy as jnp
from jax import lax
import numpy as np

D_MODEL = 1024
BATCH = 8
SEQ = 4096
DEPTH = 2

EPS = 1e-6
NEG_BIG = -1e30
LB_FLOOR = 1e-20
A_HEADS = 4
A_HEAD_DIM = 64
A_KV_LATENT = 128
IDX_HEADS = 4
IDX_DIM = 64
MAX_TOPK = 256
Q_BLOCK = 128
N_BUCKETS = 32
MAX_DISTANCE = 128
B_HEADS = 4
B_DK = 64
B_DV = 64
B_GATE_RANK = 16
B_GATE_TAU = 16.0
C_WIDTH = 256
C_BLOCKS = 4
C_CONV = 4
C_EXP = 8.0
D_HEADS = 4
D_DK = 64
D_DV = 64
CHUNK = 64
N_BRANCH = 4
D_FF = 4 * D_MODEL

IN_SPLITS = (
    A_HEADS * A_HEAD_DIM, A_KV_LATENT, IDX_HEADS * IDX_DIM, IDX_DIM, IDX_HEADS,
    B_HEADS * B_DK, B_HEADS * B_DK, B_HEADS * B_DV, B_GATE_RANK, B_HEADS * B_DV,
    C_WIDTH, C_WIDTH,
    D_HEADS * D_DK, D_HEADS * D_DK, D_HEADS * D_DV, D_HEADS * D_DV,
)
IN_COLS = sum(IN_SPLITS)

kernel_name = 'hybrid_dsa_gla_rglru_hgrn2_block'


def rms_norm(x, g):
    xf = x.astype(jnp.float32)
    y = xf * lax.rsqrt(jnp.mean(xf * xf, axis=-1, keepdims=True) + EPS)
    return (y * g.astype(jnp.float32)).astype(x.dtype)


def split_heads(t, n):
    return t.reshape(t.shape[0], t.shape[1], n, -1)


def t5_bucket(dist):
    n = jnp.maximum(dist, 0)
    max_exact = N_BUCKETS // 2
    nf = jnp.maximum(n, max_exact).astype(jnp.float32)
    large = max_exact + (jnp.log(nf / max_exact) / math.log(MAX_DISTANCE / max_exact)
                         * (N_BUCKETS - max_exact)).astype(jnp.int32)
    large = jnp.minimum(large, N_BUCKETS - 1)
    return jnp.where(n < max_exact, n, large)


def dsa_sparse_attention(q, c_kv, iq, ik, iw, w_uk, w_uv, rel_bias):
    Bsz, T = q.shape[0], q.shape[1]
    topk = min(MAX_TOPK, T // 4)
    n_blk = T // Q_BLOCK
    q_lat = jnp.einsum('bthd,hdc->bthc', q, w_uk) * (A_HEAD_DIM ** -0.5)
    iw = iw * (IDX_HEADS ** -0.5 * IDX_DIM ** -0.5)
    key_pos = jnp.arange(T, dtype=jnp.int32)
    b_idx = jnp.arange(Bsz)[:, None, None]

    def to_blocks(a):
        return jnp.swapaxes(a.reshape(Bsz, n_blk, Q_BLOCK, *a.shape[2:]), 0, 1)

    def one_block(blk):
        ql, iqb, iwb, qpos = blk
        rel = jax.nn.relu(jnp.einsum('bqhd,bsd->bqhs', iqb, ik))
        score = jnp.einsum('bqhs,bqh->bqs', rel, iwb).astype(jnp.float32)
        score = jnp.where((key_pos[None, :] <= qpos[:, None])[None], score, NEG_BIG)
        _, idx = lax.top_k(score, topk)
        c_sel = c_kv[b_idx, idx]
        dist = qpos[None, :, None] - idx
        bias = jnp.swapaxes(rel_bias[t5_bucket(dist)], -1, -2).astype(jnp.float32)
        logits = jnp.einsum('bqhc,bqkc->bqhk', ql, c_sel).astype(jnp.float32) + bias
        logits = jnp.where((dist >= 0)[:, :, None, :], logits, NEG_BIG)
        p = jax.nn.softmax(logits, axis=-1).astype(c_sel.dtype)
        return jnp.einsum('bqhk,bqkc->bqhc', p, c_sel)

    o_lat = lax.map(one_block, (to_blocks(q_lat), to_blocks(iq), to_blocks(iw),
                                key_pos.reshape(n_blk, Q_BLOCK)))
    o_lat = jnp.swapaxes(o_lat, 0, 1).reshape(Bsz, T, A_HEADS, A_KV_LATENT)
    return jnp.einsum('bthc,hcd->bthd', o_lat, w_uv)


def chunked_gated_linear_attention(q, k, v, log_g):
    Bsz, T, H, dk = q.shape
    dv = v.shape[-1]
    n = T // CHUNK

    def to_chunks(a):
        return a.reshape(Bsz, n, CHUNK, H, a.shape[-1]).transpose(1, 0, 3, 2, 4)

    xs = (to_chunks(q), to_chunks(k), to_chunks(v), to_chunks(log_g.astype(jnp.float32)))
    causal = jnp.tril(jnp.ones((CHUNK, CHUNK), dtype=bool))[None, None, :, :, None]

    def step(S, inp):
        qi, ki, vi, gi = inp
        b = jnp.cumsum(gi, axis=2)
        b_last = b[:, :, -1, :]
        diff = b[:, :, :, None, :] - b[:, :, None, :, :]
        decay = jnp.where(causal, jnp.exp(jnp.where(causal, diff, 0.0)), 0.0)
        attn = jnp.einsum('bhid,bhjd,bhijd->bhij', qi, ki, decay)
        o = (jnp.einsum('bhij,bhjv->bhiv', attn, vi)
             + jnp.einsum('bhid,bhdv->bhiv', qi * jnp.exp(b), S))
        k_tail = ki * jnp.exp(b_last[:, :, None, :] - b)
        S_new = jnp.exp(b_last)[..., None] * S + jnp.einsum('bhjd,bhjv->bhdv', k_tail, vi)
        return S_new, o

    S0 = jnp.zeros((Bsz, H, dk, dv), jnp.float32)
    _, o = lax.scan(step, S0, xs)
    return o.transpose(1, 0, 3, 2, 4).reshape(Bsz, T, H, dv).astype(v.dtype)


def causal_depthwise_conv(x, w, b):
    T = x.shape[1]
    xp = jnp.pad(x, ((0, 0), (C_CONV - 1, 0), (0, 0)))
    y = xp[:, 0:T] * w[0]
    for j in range(1, C_CONV):
        y = y + xp[:, j:j + T] * w[j]
    return y + b


def block_diag_linear(x, w, b):
    xb = x.reshape(x.shape[0], x.shape[1], C_BLOCKS, -1)
    return jnp.einsum('btni,nij->btnj', xb, w).reshape(x.shape) + b


def rg_lru(x, w_a, b_a, w_x, b_x, lam):
    r = jax.nn.sigmoid(block_diag_linear(x, w_a, b_a)).astype(jnp.float32)
    i = jax.nn.sigmoid(block_diag_linear(x, w_x, b_x)).astype(jnp.float32)
    log_a = -C_EXP * r * jax.nn.softplus(-lam.astype(jnp.float32))
    a = jnp.exp(log_a)
    u = jnp.sqrt(jnp.maximum(-jnp.expm1(2.0 * log_a), 0.0)) * (i * x.astype(jnp.float32))

    def combine(c1, c2):
        a1, u1 = c1
        a2, u2 = c2
        return a1 * a2, a2 * u1 + u2

    _, h = lax.associative_scan(combine, (a, u), axis=1)
    return h.astype(x.dtype)


def setup_inputs(seed: int = 0) -> dict:
    key = jax.random.key(seed)
    ks = iter(jax.random.split(key, 40))
    f32 = jnp.float32
    L, D = DEPTH, D_MODEL
    bs = C_WIDTH // C_BLOCKS

    def nrm(shape, scale):
        return scale * jax.random.normal(next(ks), shape, f32)

    def gain(shape):
        return 1.0 + nrm(shape, 0.02)

    a_pow = jax.random.uniform(next(ks), (L, C_WIDTH), f32, 0.9, 0.999)
    a = a_pow ** (1.0 / C_EXP)
    lru_lambda = jnp.log(a) - jnp.log1p(-a)
    wa = A_HEADS * A_HEAD_DIM
    wb = B_HEADS * B_DV
    wd = D_HEADS * D_DV
    return {
        'x': nrm((BATCH, SEQ, D), 1.0),
        'norm1_g': gain((L, D)),
        'w_in': nrm((L, D, IN_COLS), D ** -0.5),
        'w_gate': nrm((L, D, N_BRANCH * D), D ** -0.5),
        'b_gate': nrm((L, N_BRANCH * D), 0.02),
        'kv_norm_g': gain((L, A_KV_LATENT)),
        'w_uk': nrm((L, A_HEADS, A_HEAD_DIM, A_KV_LATENT), A_HEAD_DIM ** -0.5),
        'w_uv': nrm((L, A_HEADS, A_KV_LATENT, A_HEAD_DIM), A_KV_LATENT ** -0.5),
        'rel_bias': nrm((N_BUCKETS, A_HEADS), 0.2),
        'w_gk2': nrm((L, B_GATE_RANK, B_HEADS * B_DK), B_GATE_RANK ** -0.5),
        'b_gk': nrm((L, B_HEADS * B_DK), 0.1),
        'gla_norm_g': gain((L, B_DV)),
        'conv_w': nrm((L, C_CONV, C_WIDTH), C_CONV ** -0.5),
        'conv_b': nrm((L, C_WIDTH), 0.02),
        'w_rg_a': nrm((L, C_BLOCKS, bs, bs), bs ** -0.5),
        'b_rg_a': nrm((L, C_WIDTH), 0.02),
        'w_rg_x': nrm((L, C_BLOCKS, bs, bs), bs ** -0.5),
        'b_rg_x': nrm((L, C_WIDTH), 0.02),
        'lru_lambda': lru_lambda,
        'lb_param': nrm((L, D_HEADS * D_DK), 0.1),
        'hgrn_norm_g': gain((L, D_DV)),
        'w_br_a': nrm((L, wa, D), wa ** -0.5),
        'w_br_b': nrm((L, wb, D), wb ** -0.5),
        'w_br_c': nrm((L, C_WIDTH, D), C_WIDTH ** -0.5),
        'w_br_d': nrm((L, wd, D), wd ** -0.5),
        'w_out': nrm((L, D, D), D ** -0.5),
        'norm2_g': gain((L, D)),
        'w_ff1': nrm((L, D, D_FF), D ** -0.5),
        'w_ff2': nrm((L, D_FF, D), D_FF ** -0.5),
        'final_norm_g': gain((D,)),
    }


def reference(x, norm1_g, w_in, w_gate, b_gate, kv_norm_g, w_uk, w_uv, rel_bias,
              w_gk2, b_gk, gla_norm_g, conv_w, conv_b, w_rg_a, b_rg_a, w_rg_x, b_rg_x,
              lru_lambda, lb_param, hgrn_norm_g, w_br_a, w_br_b, w_br_c, w_br_d,
              w_out, norm2_g, w_ff1, w_ff2, final_norm_g):
    Bsz, T, D = x.shape
    offsets = np.cumsum(IN_SPLITS)[:-1].tolist()
    lb_soft = jax.nn.softmax(lb_param.astype(jnp.float32), axis=0)
    lower_bounds = jnp.cumsum(lb_soft, axis=0) - lb_soft[0]
    for l in range(DEPTH):
        h = rms_norm(x, norm1_g[l])
        (a_q, a_ckv, a_iq, a_ik, a_iw,
         b_q, b_k, b_v, b_lr, b_r,
         c_x, c_y,
         d_q, d_f, d_i, d_g) = jnp.split(h @ w_in[l], offsets, axis=-1)

        y_a = dsa_sparse_attention(split_heads(a_q, A_HEADS), rms_norm(a_ckv, kv_norm_g[l]),
                                   split_heads(a_iq, IDX_HEADS), a_ik, a_iw,
                                   w_uk[l], w_uv[l], rel_bias).reshape(Bsz, T, -1)

        log_alpha = jax.nn.log_sigmoid((b_lr @ w_gk2[l] + b_gk[l]).astype(jnp.float32)) / B_GATE_TAU
        o_b = chunked_gated_linear_attention(split_heads(b_q, B_HEADS) * (B_DK ** -0.5),
                                             split_heads(b_k, B_HEADS), split_heads(b_v, B_HEADS),
                                             split_heads(log_alpha, B_HEADS))
        y_b = (rms_norm(o_b, gla_norm_g[l]) * jax.nn.silu(split_heads(b_r, B_HEADS))).reshape(Bsz, T, -1)

        xc = causal_depthwise_conv(c_x, conv_w[l], conv_b[l])
        y_c = rg_lru(xc, w_rg_a[l], b_rg_a[l], w_rg_x[l], b_rg_x[l], lru_lambda[l]) * jax.nn.gelu(c_y)

        lb = lower_bounds[l]
        log_f = jnp.logaddexp(jnp.log(jnp.maximum(lb, LB_FLOOR)),
                              jnp.log1p(-lb) + jax.nn.log_sigmoid(d_f.astype(jnp.float32)))
        o_d = chunked_gated_linear_attention(split_heads(jax.nn.silu(d_q), D_HEADS),
                                             split_heads(-jnp.expm1(log_f), D_HEADS),
                                             split_heads(d_i, D_HEADS), split_heads(log_f, D_HEADS))
        y_d = (rms_norm(o_d, hgrn_norm_g[l]) * jax.nn.silu(split_heads(d_g, D_HEADS))).reshape(Bsz, T, -1)

        gates = jax.nn.sigmoid(h @ w_gate[l] + b_gate[l]).reshape(Bsz, T, N_BRANCH, D)
        merged = (gates[:, :, 0] * (y_a @ w_br_a[l]) + gates[:, :, 1] * (y_b @ w_br_b[l])
                  + gates[:, :, 2] * (y_c @ w_br_c[l]) + gates[:, :, 3] * (y_d @ w_br_d[l]))
        x = x + merged @ w_out[l]

        h2 = rms_norm(x, norm2_g[l])
        x = x + jnp.square(jax.nn.relu(h2 @ w_ff1[l])) @ w_ff2[l]
    return rms_norm(x, final_norm_g)
```

```cpp
#include <hip/hip_runtime.h>
#include <cstdio>
#include <cstdint>
#ifndef STAGGER_TICKS
#define STAGGER_TICKS 0
#endif

namespace pg8 {
#define PG8_LAS __attribute__((address_space(3)))
typedef unsigned short bf16_t;
typedef short bf16x8 __attribute__((ext_vector_type(8)));
typedef float f32x4 __attribute__((ext_vector_type(4)));
typedef unsigned u32x4 __attribute__((ext_vector_type(4)));
constexpr int BM = 256, BK = 64, HALF = 128, HTB = HALF * BK * 2  , STAGE_BYTES = 8 * HTB, NXCD = 8, WGM = 4;

__host__ __device__ __forceinline__ int lds_byte(int r, int c) { const int st = (r >> 4) * 2 + (c >> 5), rr = r & 15, cc = c & 31, ob = rr * 64 + cc * 2; return st * 1024 + (ob ^ (((ob >> 9) & 1) << 5)); }
__host__ __device__ __forceinline__ void stage_rc(int b, int& R, int& C) { const int st = b / 1024, sb = b % 1024, swz = sb ^ (((sb >> 9) & 1) << 5); R = (st >> 1) * 16 + swz / 64; C = (st & 1) * 32 + (swz % 64) / 2; }
__host__ __device__ __forceinline__ int perm32(int rho) { const int n = rho >> 4, i = rho & 15; return 8 * (i >> 2) + 4 * n + (i & 3); }

struct Unit { int pm, pn; };
struct Gemm { const bf16_t* A; const bf16_t* Bt; int M, N, K; int atile = 0; };

struct StaticOrder {
    int nM, nN, nwg, G, c;
    __host__ __device__ void init(int M, int N, int G_, int c_) { nM = M / BM; nN = N / BM; nwg = nM * nN; G = G_; c = c_; }
    __host__ __device__ bool next(int i, Unit& u) const {
        const long L = (long)i * G + c; if (L >= nwg) return false;
        int wgid = (int)L; { const int q = nwg / NXCD, r = nwg % NXCD, xcd = wgid % NXCD, off = wgid / NXCD; wgid = (xcd < r ? xcd * (q + 1) : r * (q + 1) + (xcd - r) * q) + off; }
        const int nig = WGM * nN, gid = wgid / nig, fm = gid * WGM, gsz = (nM - fm) < WGM ? (nM - fm) : WGM;
        u.pm = fm + ((wgid % nig) % gsz); u.pn = (wgid % nig) / gsz; return true;
    }
    __device__ __forceinline__ void a_ready(const Unit&) const {}
    __device__ __forceinline__ void done(const Unit&) const {}
};
__device__ __forceinline__ unsigned cvt_pk_bf16(float lo, float hi) { unsigned r; asm volatile("v_cvt_pk_bf16_f32 %0, %1, %2" : "=v"(r) : "v"(lo), "v"(hi)); return r; }
template <class Epi, class Sched, bool ALIGN_EPI = false, bool SP2 = false, bool RELAX = false>
__device__ __forceinline__ void gemm_phase(PG8_LAS unsigned char* lds, const Gemm g, const Sched& S, const Epi& E, int tid_in) {
    int tid_ = tid_in; asm volatile("" : "+v"(tid_));
    const int tid = tid_, wid = __builtin_amdgcn_readfirstlane(tid >> 6), lane = tid & 63, wr = wid >> 2, wc = wid & 3, fr = lane & 15, fq = lane >> 4;
    const int K = g.K, nt = K / BK;
    unsigned voffA[2], voffB[2];
#pragma unroll
    for (int i = 0; i < 2; ++i) { int R, C; stage_rc(tid * 16 + i * 8192, R, C); const int Rb = Epi::PERM ? ((R & ~31) + perm32(R & 31)) : R;
        voffA[i] = g.atile ? (unsigned)(R * BK + C) * 2u : (unsigned)(R * K + C) * 2u; voffB[i] = (unsigned)(Rb * K + C) * 2u; }
    const size_t kstep = (size_t)(BK * 2);
    const size_t hstep = (size_t)HALF * K * 2;
    const size_t kstepA = g.atile ? (size_t)(BM * BK * 2) : kstep, hstepA = g.atile ? (size_t)(HALF * BK * 2) : hstep;
    const size_t tstep = 2 * hstep;
    const unsigned ldsw = (unsigned)wid * 1024u;
    const int aoff = lds_byte(wr * 64 + fr, fq * 8), boff = lds_byte(wc * 32 + fr, fq * 8);
#define PG8_SA(b, h) (((b) * 2 + (h)) * HTB)
#define PG8_SB(b, h) ((4 + (b) * 2 + (h)) * HTB)
#define PG8_STAGE(bufoff, gbase, voff) do { _Pragma("unroll") for (int _i = 0; _i < 2; ++_i) \
        __builtin_amdgcn_global_load_lds((const unsigned*)((const char*)(gbase) + (voff)[_i]), (PG8_LAS unsigned*)(lds + (bufoff) + ldsw + _i * 8192), 16, 0, 0); } while (0)
#define PG8_LDA(dst, b, h) do { _Pragma("unroll") for (int m = 0; m < 4; ++m) _Pragma("unroll") for (int k = 0; k < 2; ++k) dst[m][k] = *(const PG8_LAS bf16x8*)(lds + PG8_SA(b, h) + aoff + m * 2048 + k * 1024); } while (0)
#define PG8_LDB(dst, b, h) do { _Pragma("unroll") for (int n = 0; n < 2; ++n) _Pragma("unroll") for (int k = 0; k < 2; ++k) dst[n][k] = *(const PG8_LAS bf16x8*)(lds + PG8_SB(b, h) + boff + n * 2048 + k * 1024); } while (0)
#define PG8_MMA(ai, bj, At, Bt) do { __builtin_amdgcn_s_setprio(1); _Pragma("unroll") for (int m = 0; m < 4; ++m) _Pragma("unroll") for (int n = 0; n < 2; ++n) _Pragma("unroll") for (int k = 0; k < 2; ++k) \
        acc[ai][bj][m][n] = __builtin_amdgcn_mfma_f32_16x16x32_bf16(Bt[n][k], At[m][k], acc[ai][bj][m][n], 0, 0, 0); __builtin_amdgcn_s_setprio(0); } while (0)
#define PG8_WAIT_V(n) asm volatile("s_waitcnt vmcnt(" #n ")" ::: "memory")
#define PG8_WAIT_L(n) asm volatile("s_waitcnt lgkmcnt(" #n ")" ::: "memory")
#define PG8_WAIT_VR() asm volatile("s_waitcnt vmcnt(%0)" :: "n"(8 + Epi::NST) : "memory")
#define PG8_BAR __builtin_amdgcn_s_barrier()
#define PG8_SCHED __builtin_amdgcn_sched_barrier(0)
    Unit cur, nxt; int ui = 0;
    if (!S.next(0, cur)) return;
    f32x4 acc[2][2][4][2];
#pragma unroll
    for (int a = 0; a < 2; ++a)
#pragma unroll
        for (int b = 0; b < 2; ++b)
#pragma unroll
            for (int m = 0; m < 4; ++m)
#pragma unroll
                for (int n = 0; n < 2; ++n) { acc[a][b][m][n] = (f32x4){0.f, 0.f, 0.f, 0.f}; if constexpr (RELAX) asm volatile("" : "+v"(acc[a][b][m][n])); }
    bf16x8 At[4][2], B0[2][2], B1[2][2];
    const char* cA = (const char*)g.A + (size_t)cur.pm * tstep; const char* cB = (const char*)g.Bt + (size_t)cur.pn * tstep;
    S.a_ready(cur);
    if constexpr (RELAX) {
        PG8_STAGE(PG8_SB(0, 0), cB, voffB); PG8_STAGE(PG8_SB(0, 1), cB + hstep, voffB); PG8_STAGE(PG8_SA(0, 0), cA, voffA); PG8_STAGE(PG8_SA(0, 1), cA + hstepA, voffA);
        PG8_STAGE(PG8_SB(1, 0), cB + kstep, voffB); PG8_STAGE(PG8_SA(1, 0), cA + kstepA, voffA); PG8_STAGE(PG8_SB(1, 1), cB + hstep + kstep, voffB); PG8_STAGE(PG8_SA(1, 1), cA + hstepA + kstepA, voffA);
        PG8_WAIT_V(0); PG8_BAR;
        if (wr == 1) PG8_BAR;
    } else if constexpr (SP2) {
        PG8_STAGE(PG8_SB(0, 0), cB, voffB); PG8_STAGE(PG8_SB(0, 1), cB + hstep, voffB); PG8_STAGE(PG8_SA(0, 0), cA, voffA); PG8_STAGE(PG8_SA(0, 1), cA + hstepA, voffA);
        if (wr == 1) PG8_BAR;
        PG8_WAIT_V(2); PG8_BAR;
        PG8_STAGE(PG8_SB(1, 0), cB + kstep, voffB); PG8_STAGE(PG8_SA(1, 0), cA + kstepA, voffA); PG8_STAGE(PG8_SB(1, 1), cB + hstep + kstep, voffB);
        PG8_WAIT_V(6); PG8_BAR;
    } else {
        PG8_STAGE(PG8_SB(0, 0), cB, voffB); PG8_STAGE(PG8_SA(0, 0), cA, voffA); PG8_STAGE(PG8_SB(0, 1), cB + hstep, voffB); PG8_STAGE(PG8_SA(0, 1), cA + hstepA, voffA);
        if (wr == 1) PG8_BAR;
        PG8_WAIT_V(4); PG8_BAR;
        PG8_STAGE(PG8_SB(1, 0), cB + kstep, voffB); PG8_STAGE(PG8_SA(1, 0), cA + kstepA, voffA); PG8_STAGE(PG8_SB(1, 1), cB + hstep + kstep, voffB);
        PG8_WAIT_V(6); PG8_BAR;
    }
#define PG8_TRIP_SP2(REL) do { \
        PG8_LDB(B0, 0, 0); PG8_LDB(B1, 0, 1); PG8_SCHED; PG8_LDA(At, 0, 0); if (!(REL)) PG8_STAGE(PG8_SA(1, 1), a1 + hstepA, voffA); \
        if (REL) PG8_WAIT_VR(); else PG8_WAIT_V(8); PG8_WAIT_L(0); PG8_BAR; PG8_MMA(0, 0, At, B0); PG8_MMA(0, 1, At, B1); PG8_BAR; PG8_SCHED; \
        PG8_LDA(At, 0, 1); PG8_STAGE(PG8_SB(0, 0), b2, voffB); PG8_STAGE(PG8_SB(0, 1), b2 + hstep, voffB); PG8_STAGE(PG8_SA(0, 0), a2, voffA); \
        if (REL) PG8_WAIT_VR(); else PG8_WAIT_V(8); PG8_WAIT_L(0); PG8_BAR; PG8_MMA(1, 0, At, B0); PG8_MMA(1, 1, At, B1); PG8_BAR; PG8_SCHED; \
        PG8_LDB(B0, 1, 0); PG8_LDB(B1, 1, 1); PG8_SCHED; PG8_LDA(At, 1, 0); PG8_STAGE(PG8_SA(0, 1), a2 + hstepA, voffA); \
        if (REL) PG8_WAIT_VR(); else PG8_WAIT_V(8); PG8_WAIT_L(0); PG8_BAR; PG8_MMA(0, 0, At, B0); PG8_MMA(0, 1, At, B1); PG8_BAR; PG8_SCHED; \
        PG8_LDA(At, 1, 1); PG8_STAGE(PG8_SB(1, 0), b3, voffB); PG8_STAGE(PG8_SB(1, 1), b3 + hstep, voffB); PG8_STAGE(PG8_SA(1, 0), a3, voffA); \
        PG8_WAIT_V(8); PG8_WAIT_L(0); PG8_BAR; PG8_MMA(1, 0, At, B0); PG8_MMA(1, 1, At, B1); PG8_BAR; PG8_SCHED; } while (0)
    if constexpr (RELAX) {
        static_assert(SP2 && ALIGN_EPI && !Epi::AFTER_DRAIN, "RELAX variant");
        for (;;) {
            const bool has_next = S.next(ui + 1, nxt);
            const char* nA = has_next ? (const char*)g.A + (size_t)nxt.pm * tstep : cA; const char* nB = has_next ? (const char*)g.Bt + (size_t)nxt.pn * tstep : cB;
            int t1 = 2; asm volatile("" : "+s"(t1));
            for (int t = 0; t < t1; t += 2) { const char* a1 = cA; (void)a1; const char* a2 = cA + (size_t)(t + 2) * kstepA; const char* b2 = cB + (size_t)(t + 2) * kstep; const char* a3 = a2 + kstepA; const char* b3 = b2 + kstep; PG8_TRIP_SP2(1); }
            for (int t = 2; t < nt; t += 2) {
                const bool last = (t == nt - 2);
                const char* a1 = cA + (size_t)(t + 1) * kstepA;
                const char* a2 = last ? nA : cA + (size_t)(t + 2) * kstepA; const char* b2 = last ? nB : cB + (size_t)(t + 2) * kstep;
                const char* a3 = a2 + kstepA; const char* b3 = b2 + kstep;
                PG8_TRIP_SP2(0);
            }
            if (has_next) PG8_STAGE(PG8_SA(1, 1), nA + kstepA + hstepA, voffA);
            if (wr == 0) PG8_BAR;
            E(acc, cur, wr, wc, fr, fq); S.done(cur);
            if (!has_next) break;
#pragma unroll
            for (int a = 0; a < 2; ++a)
#pragma unroll
                for (int b = 0; b < 2; ++b)
#pragma unroll
                    for (int m = 0; m < 4; ++m)
#pragma unroll
                        for (int n = 0; n < 2; ++n) { acc[a][b][m][n] = (f32x4){0.f, 0.f, 0.f, 0.f}; asm volatile("" : "+v"(acc[a][b][m][n])); }
            cur = nxt; cA = nA; cB = nB; ++ui;
            if (wr == 1) PG8_BAR;
        }
    } else {
    for (;;) {
        const bool has_next = S.next(ui + 1, nxt);
        const char* nA = has_next ? (const char*)g.A + (size_t)nxt.pm * tstep : cA; const char* nB = has_next ? (const char*)g.Bt + (size_t)nxt.pn * tstep : cB;
        for (int t = 0; t < nt; t += 2) {
            const bool last = (t == nt - 2);
            const char* a1 = cA + (size_t)(t + 1) * kstepA;
            const char* a2 = last ? nA : cA + (size_t)(t + 2) * kstepA; const char* b2 = last ? nB : cB + (size_t)(t + 2) * kstep;
            const char* a3 = a2 + kstepA; const char* b3 = b2 + kstep;
            if (last && has_next) S.a_ready(nxt);
            if constexpr (SP2) {
            PG8_LDB(B0, 0, 0); PG8_LDB(B1, 0, 1); PG8_SCHED; PG8_LDA(At, 0, 0); PG8_STAGE(PG8_SA(1, 1), a1 + hstepA, voffA);
            PG8_WAIT_V(8); PG8_WAIT_L(0); PG8_BAR; PG8_MMA(0, 0, At, B0); PG8_MMA(0, 1, At, B1); PG8_BAR; PG8_SCHED;
            PG8_LDA(At, 0, 1); PG8_STAGE(PG8_SB(0, 0), b2, voffB); PG8_STAGE(PG8_SB(0, 1), b2 + hstep, voffB); PG8_STAGE(PG8_SA(0, 0), a2, voffA);
            PG8_WAIT_V(8); PG8_WAIT_L(0); PG8_BAR; PG8_MMA(1, 0, At, B0); PG8_MMA(1, 1, At, B1); PG8_BAR; PG8_SCHED;
            PG8_LDB(B0, 1, 0); PG8_LDB(B1, 1, 1); PG8_SCHED; PG8_LDA(At, 1, 0); PG8_STAGE(PG8_SA(0, 1), a2 + hstepA, voffA);
            PG8_WAIT_V(8); PG8_WAIT_L(0); PG8_BAR; PG8_MMA(0, 0, At, B0); PG8_MMA(0, 1, At, B1); PG8_BAR; PG8_SCHED;
            PG8_LDA(At, 1, 1); PG8_STAGE(PG8_SB(1, 0), b3, voffB); PG8_STAGE(PG8_SB(1, 1), b3 + hstep, voffB); PG8_STAGE(PG8_SA(1, 0), a3, voffA);
            PG8_WAIT_V(8); PG8_WAIT_L(0); PG8_BAR; PG8_MMA(1, 0, At, B0); PG8_MMA(1, 1, At, B1); PG8_BAR; PG8_SCHED;
            } else {
            PG8_LDB(B0, 0, 0); PG8_SCHED; PG8_LDA(At, 0, 0); PG8_STAGE(PG8_SA(1, 1), a1 + hstepA, voffA);
            PG8_WAIT_L(8); PG8_BAR; PG8_WAIT_L(0); PG8_MMA(0, 0, At, B0); PG8_BAR; PG8_SCHED;
            PG8_LDB(B1, 0, 1); PG8_STAGE(PG8_SB(0, 0), b2, voffB);
            PG8_BAR; PG8_WAIT_L(0); PG8_MMA(0, 1, At, B1); PG8_BAR;
            PG8_LDA(At, 0, 1); PG8_STAGE(PG8_SA(0, 0), a2, voffA);
            PG8_BAR; PG8_WAIT_L(0); PG8_MMA(1, 0, At, B0); PG8_BAR; PG8_SCHED;
            PG8_STAGE(PG8_SB(0, 1), b2 + hstep, voffB);
            PG8_WAIT_V(6); PG8_BAR; PG8_MMA(1, 1, At, B1); PG8_BAR;
            PG8_LDB(B0, 1, 0); PG8_SCHED; PG8_LDA(At, 1, 0); PG8_STAGE(PG8_SA(0, 1), a2 + hstepA, voffA);
            PG8_WAIT_L(8); PG8_BAR; PG8_WAIT_L(0); PG8_MMA(0, 0, At, B0); PG8_BAR; PG8_SCHED;
            PG8_LDB(B1, 1, 1); PG8_STAGE(PG8_SB(1, 0), b3, voffB);
            PG8_BAR; PG8_WAIT_L(0); PG8_MMA(0, 1, At, B1); PG8_BAR;
            PG8_LDA(At, 1, 1); PG8_STAGE(PG8_SA(1, 0), a3, voffA);
            PG8_BAR; PG8_WAIT_L(0); PG8_MMA(1, 0, At, B0); PG8_BAR; PG8_SCHED;
            PG8_STAGE(PG8_SB(1, 1), b3 + hstep, voffB);
            PG8_WAIT_V(6); PG8_BAR; PG8_MMA(1, 1, At, B1); PG8_BAR;
            }
        }
        if constexpr (ALIGN_EPI) { if (wr == 0) PG8_BAR; }
        if constexpr (!Epi::AFTER_DRAIN) { E(acc, cur, wr, wc, fr, fq); S.done(cur); }
        if (!has_next) break;
#pragma unroll
        for (int a = 0; a < 2; ++a)
#pragma unroll
            for (int b = 0; b < 2; ++b)
#pragma unroll
                for (int m = 0; m < 4; ++m)
#pragma unroll
                    for (int n = 0; n < 2; ++n) acc[a][b][m][n] = (f32x4){0.f, 0.f, 0.f, 0.f};
        cur = nxt; cA = nA; cB = nB; ++ui;
        if constexpr (ALIGN_EPI) { if (wr == 1) PG8_BAR; }
    }
    }
    PG8_WAIT_V(0);
    if constexpr (!ALIGN_EPI) { if (wr == 0) PG8_BAR; }
    PG8_BAR;
    if constexpr (Epi::AFTER_DRAIN) { E.fused(acc, cur, wr, wc, fr, fq, lds, wid, lane); S.done(cur); }
#undef PG8_SA
#undef PG8_SB
#undef PG8_STAGE
#undef PG8_LDA
#undef PG8_LDB
#undef PG8_MMA
#undef PG8_WAIT_V
#undef PG8_WAIT_L
#undef PG8_BAR
#undef PG8_SCHED
#undef PG8_TRIP_SP2
#undef PG8_WAIT_VR
}
}

constexpr int NBATCH = 8, SEQ = 4096, DM = 1024, DEPTH = 2, DFF = 4096;
constexpr int M = NBATCH * SEQ;
constexpr int IN_COLS = 3284;
constexpr int NIN = 3584;
constexpr int A16_LD = 3328, A32_LD = 256;
constexpr float EPS = 1e-6f;
constexpr int TOPK = 256;
constexpr int C_QL = 0, C_IQ = 512, C_BQ = 768, C_BK = 1024, C_BV = 1280, C_BR = 1536, C_CY = 1792, C_DQ = 2048, C_DI = 2304, C_DG = 2560;
constexpr int C_CKV = 0, C_IK = 128, C_IW = 192, C_LR = 196;
constexpr int C_CX = 2816, C_DF = 3072;

constexpr size_t MiB = 1u << 20;
constexpr size_t WS_CTL = 0, CTL_ZERO_BYTES = 65536;
constexpr size_t WS_TAB = 1 * MiB;
constexpr size_t WS_RSS = 2 * MiB;
constexpr size_t WS_CKSS = 3 * MiB + 512 * 1024;
constexpr size_t WS_W = 4 * MiB;
constexpr size_t W_IN = 0, W_GATE = 7340032, W_BRA = 15728640, W_BRB = 16777216, W_BRC = 17301504, W_BRD = 17825792, W_OUT = 18350080, W_FF1 = 20447232, W_FF2 = 28835840, W_LAYER = 37224448;
constexpr size_t WS_XB = 76 * MiB;
constexpr size_t WS_A16 = 140 * MiB;
constexpr size_t WS_A32 = 348 * MiB;
constexpr size_t WS_P = 140 * MiB;
constexpr size_t WS_HID = 140 * MiB;
constexpr size_t WS_OLAT = 412 * MiB, WS_YB = 444 * MiB, WS_YC = 460 * MiB, WS_YD = 476 * MiB;
constexpr size_t WS_MRG = 412 * MiB;
constexpr size_t WS_CKV = 492 * MiB;
constexpr size_t WS_IK = 500 * MiB;
constexpr size_t WS_CKVT = 504 * MiB;
constexpr size_t WS_END = 512 * MiB;
static_assert(WS_W + 2 * W_LAYER <= WS_XB && WS_A16 + (size_t)M * A16_LD * 2 <= WS_A32 && WS_A32 + (size_t)M * A32_LD * 4 <= WS_OLAT && WS_P + (size_t)M * 4096 * 2 <= WS_OLAT, "ws map");
constexpr int CW_TMO = 0;
constexpr int CW_BAR = 4096;

constexpr int RING_BYTES = 131072;
constexpr int LDSCTL_OFF = RING_BYTES, MISC_OFF = LDSCTL_OFF + 320;
constexpr int LDS_BYTES = 147456;
constexpr int NWAVES = 8;

#define GAS __attribute__((address_space(1)))
#define LAS __attribute__((address_space(3)))
typedef unsigned short bf16;
typedef float f32x4 __attribute__((ext_vector_type(4)));
typedef float f32x2 __attribute__((ext_vector_type(2)));
typedef unsigned u32x4 __attribute__((ext_vector_type(4)));
typedef unsigned u32x2 __attribute__((ext_vector_type(2)));

typedef __bf16 bf16x2_t __attribute__((ext_vector_type(2)));
__device__ __forceinline__ unsigned pk2(float lo, float hi) { bf16x2_t v; v[0] = (__bf16)lo; v[1] = (__bf16)hi; return __builtin_bit_cast(unsigned, v); }
__device__ __forceinline__ unsigned f2bf(float f) { return (unsigned)__builtin_bit_cast(unsigned short, (__bf16)f); }
__device__ __forceinline__ float bf2f(unsigned b) { return __uint_as_float(b << 16); }
__device__ __forceinline__ float bflo(unsigned w) { return __uint_as_float(w << 16); }
__device__ __forceinline__ float bfhi(unsigned w) { return __uint_as_float(w & 0xffff0000u); }
__device__ __forceinline__ float fsigmoid(float x) { return __builtin_amdgcn_rcpf(1.0f + __builtin_amdgcn_exp2f(-1.44269504f * x)); }
__device__ __forceinline__ float fsilu(float x) { return x * fsigmoid(x); }
__device__ __forceinline__ float fgelu_tanh(float x) { return x * fsigmoid(1.59576912f * (x + 0.044715f * x * x * x)); }
__device__ __forceinline__ float flogsigmoid(float x) { return -fmaxf(-x, 0.f) - 0.69314718f * __builtin_amdgcn_logf(1.0f + __builtin_amdgcn_exp2f(-1.44269504f * fabsf(x))); }
typedef unsigned long long rss_t;
__device__ __forceinline__ rss_t rss_enc(float ss) { return (rss_t)(ss * 1048576.0f + 0.5f); }
__device__ __forceinline__ float rss_dec(rss_t q) { return (float)q * (1.0f / 1048576.0f); }
__device__ __forceinline__ float wave_sum(float v) {
#pragma unroll
    for (int o = 1; o < 64; o <<= 1) v += __shfl_xor(v, o);
    return v;
}
__device__ __forceinline__ float wave_max(float v) {
#pragma unroll
    for (int o = 1; o < 64; o <<= 1) v = fmaxf(v, __shfl_xor(v, o));
    return v;
}
__device__ __forceinline__ int wave_isum(int v) {
#pragma unroll
    for (int o = 1; o < 64; o <<= 1) v += __shfl_xor(v, o);
    return v;
}

#define XB_TMO      128
#define XB_XCNT(j)  (256  + 64 * (j))
#define XB_XSUB(j)  (1280 + 64 * (j))
#define XB_XGEN(j)  (2304 + 64 * (j))
#define XB_TOP      3328
#define XB_TOPGEN   3392
#define XCD_BAR_WORDS 3456
#define XB_SPIN_CAP (1u << 18)
__device__ __forceinline__ unsigned xb_ld(unsigned* p)              { return __hip_atomic_load(p, __ATOMIC_RELAXED, __HIP_MEMORY_SCOPE_AGENT); }
__device__ __forceinline__ unsigned xb_add(unsigned* p, unsigned v) { return __hip_atomic_fetch_add(p, v, __ATOMIC_RELAXED, __HIP_MEMORY_SCOPE_AGENT); }
__device__ __forceinline__ unsigned xb_xcc_id() { return (unsigned)__builtin_amdgcn_s_getreg((3 << 11) | 20) & 0xFu; }
#define XB_SPIN(cond, bar) do { unsigned _sp = 0; while (cond) { __builtin_amdgcn_s_sleep(1); \
    if ((++_sp & 255u) == 0u) { if (xb_ld(&(bar)[XB_TMO])) break; if (_sp > XB_SPIN_CAP) { atomicAdd(&(bar)[XB_TMO], 1u); break; } } } } while (0)
struct XcdBarrier { unsigned* bar; unsigned x; volatile LAS unsigned* st; };
__device__ __forceinline__ XcdBarrier xcd_barrier_post(unsigned* bar, volatile LAS unsigned* st) {
    XcdBarrier b; b.bar = bar; b.x = xb_xcc_id(); b.st = st;
    if (threadIdx.x == 0) (void)xb_add(&bar[XB_XCNT(b.x)], 1u);
    return b;
}
__device__ __forceinline__ void xcd_barrier_complete(unsigned* bar, unsigned x, unsigned& nloc, unsigned& nx) {
    const unsigned G = gridDim.x * gridDim.y * gridDim.z;
    unsigned sum, cnt, mine, sp = 0u;
    for (;;) {
        sum = 0u; cnt = 0u; mine = 0u;
#pragma unroll
        for (unsigned j = 0; j < 16; ++j) { const unsigned c = xb_ld(&bar[XB_XCNT(j)]); sum += c; cnt += (c > 0u) ? 1u : 0u; mine = (j == x) ? c : mine; }
        if (sum == G) break;
        __builtin_amdgcn_s_sleep(1);
        if ((++sp & 255u) == 0u) { if (xb_ld(&bar[XB_TMO])) break; if (sp > XB_SPIN_CAP) { atomicAdd(&bar[XB_TMO], 1u); break; } }
    }
    nloc = mine > 0u ? mine : 1u; nx = cnt > 0u ? cnt : 1u;
}
__device__ __forceinline__ void xcd_barrier(const XcdBarrier& b, bool is_t0) {
    asm volatile("s_waitcnt vmcnt(0)" ::: "memory");
    __syncthreads();
    if (is_t0) {
        unsigned* bar = b.bar;
        __builtin_amdgcn_s_waitcnt(0);
        unsigned nloc = b.st[0], nx = b.st[1];
        if (nloc == 0u) { xcd_barrier_complete(bar, b.x, nloc, nx); b.st[0] = nloc; b.st[1] = nx; }
        const unsigned old = xb_add(&bar[XB_XSUB(b.x)], 1u);
        const unsigned gen = old / nloc;
        if (old + 1u == (gen + 1u) * nloc) {
            __builtin_amdgcn_fence(__ATOMIC_RELEASE, "agent");
            asm volatile("s_waitcnt vmcnt(0)" ::: "memory");
            const unsigned og = xb_add(&bar[XB_TOP], 1u);
            const unsigned tg = og / nx;
            if (og + 1u == (tg + 1u) * nx) xb_add(&bar[XB_TOPGEN], 1u);
            else XB_SPIN(xb_ld(&bar[XB_TOPGEN]) == tg, bar);
            __builtin_amdgcn_fence(__ATOMIC_ACQUIRE, "agent");
            xb_add(&bar[XB_XGEN(b.x)], 1u);
            asm volatile("s_waitcnt vmcnt(0)" ::: "memory");
        } else {
            XB_SPIN(xb_ld(&bar[XB_XGEN(b.x)]) == gen, bar);
            __builtin_amdgcn_fence(__ATOMIC_ACQUIRE, "agent");
            asm volatile("s_waitcnt vmcnt(0)" ::: "memory");
        }
    }
    __syncthreads();
}

#ifndef USE_NT
#define USE_NT 0
#endif
#ifndef USE_SC1
#define USE_SC1 1
#endif
__device__ __forceinline__ void st_wt(u32x4* p, u32x4 v) { asm volatile("global_store_dwordx4 %0, %1, off sc1\n\ts_nop 1" :: "v"(p), "v"(v) : "memory"); }
__device__ __forceinline__ void st_wt(f32x4* p, f32x4 v) { asm volatile("global_store_dwordx4 %0, %1, off sc1\n\ts_nop 1" :: "v"(p), "v"(v) : "memory"); }
__device__ __forceinline__ void st_wt(u32x2* p, u32x2 v) { asm volatile("global_store_dwordx2 %0, %1, off sc1\n\ts_nop 1" :: "v"(p), "v"(v) : "memory"); }
#ifndef SC1_MASK
#define SC1_MASK 0x10u
#endif
#define ST_POL(bit, p, v) do { if ((SC1_MASK >> (bit)) & 1u) st_wt((p), (v)); else *(p) = (v); } while (0)
struct EpiInProj {
    static constexpr bool PERM = true, AFTER_DRAIN = false, PROBE2 = true;
    static constexpr int NST = 16;
    bf16* a16; float* a32; const rss_t* rss; const LAS float* lbA; const LAS float* lbB;
    bf16* ckv; bf16* ik; rss_t* ckss;
    __device__ __forceinline__ void operator()(const pg8::f32x4 (&acc)[2][2][4][2], const pg8::Unit& u, int wr, int wc, int fr, int fq) const {
        const int pn = u.pn, row0 = u.pm * 256 + wr * 64 + fr, cl = wc * 32 + 8 * fq;
        float ssv[8]; rss_t ssr[8];
#pragma unroll
        for (int g = 0; g < 8; ++g) ssr[g] = rss[row0 + (g >> 2) * 128 + (g & 3) * 16];
        asm volatile("" : "+v"(ssr[0]), "+v"(ssr[1]), "+v"(ssr[2]), "+v"(ssr[3]), "+v"(ssr[4]), "+v"(ssr[5]), "+v"(ssr[6]), "+v"(ssr[7]) :: "memory");
#pragma unroll
        for (int g = 0; g < 8; ++g) ssv[g] = rss_dec(ssr[g]);
        if (pn != 11) {
            const int act = (pn == 6 || pn == 8 || pn == 10) ? 1 : (pn == 7 ? 2 : (pn == 13 ? 3 : 0)), pc = pn < 11 ? pn : pn - 1;
#pragma unroll
            for (int ai = 0; ai < 2; ++ai)
#pragma unroll
                for (int m = 0; m < 4; ++m) { bf16* rowp = a16 + (size_t)(row0 + ai * 128 + m * 16) * A16_LD + pc * 256 + cl; const float sc = __builtin_amdgcn_rsqf(ssv[ai * 4 + m] * (1.0f / DM) + EPS);
#pragma unroll
                    for (int bj = 0; bj < 2; ++bj) { float v[8];
#pragma unroll
                        for (int j = 0; j < 4; ++j) { v[j] = acc[ai][bj][m][0][j] * sc; v[4 + j] = acc[ai][bj][m][1][j] * sc; }
                        if (act == 1) {
#pragma unroll
                            for (int j = 0; j < 8; ++j) v[j] = fsilu(v[j]); }
                        else if (act == 2) {
#pragma unroll
                            for (int j = 0; j < 8; ++j) v[j] = fgelu_tanh(v[j]); }
                        else if (act == 3) {
#pragma unroll
                            for (int n = 0; n < 2; ++n) { const f32x4 la = *(const LAS f32x4*)(lbA + cl + bj * 128 + 4 * n), lb = *(const LAS f32x4*)(lbB + cl + bj * 128 + 4 * n);
#pragma unroll
                                for (int j = 0; j < 4; ++j) { const float b = lb[j] + flogsigmoid(v[4 * n + j]), a = la[j]; const float mx = fmaxf(a, b), d = -fabsf(a - b);
                                    v[4 * n + j] = mx + 0.69314718f * __builtin_amdgcn_logf(1.0f + __builtin_amdgcn_exp2f(1.44269504f * d)); } } }
                        u32x4 w; w.x = pk2(v[0], v[1]); w.y = pk2(v[2], v[3]); w.z = pk2(v[4], v[5]); w.w = pk2(v[6], v[7]);
                        ST_POL(0, (u32x4*)(rowp + bj * 128), w); }
                    asm volatile("" ::: "memory"); }
        } else {
#pragma unroll
            for (int ai = 0; ai < 2; ++ai)
#pragma unroll
                for (int m = 0; m < 4; ++m) { float* rowp = a32 + (size_t)(row0 + ai * 128 + m * 16) * A32_LD + cl; const float sc = __builtin_amdgcn_rsqf(ssv[ai * 4 + m] * (1.0f / DM) + EPS);
                    if (wc >= 2) {
#pragma unroll
                        for (int n = 0; n < 2; ++n) { const f32x4 v = acc[ai][1][m][n] * sc; ST_POL(0, (f32x4*)(rowp + 128 + 4 * n), v); } }
                    { const int r_ = row0 + ai * 128 + m * 16;
                        const f32x4 c0 = acc[ai][0][m][0] * sc, c1 = acc[ai][0][m][1] * sc;
                        u32x4 w; w.x = pk2(c0[0], c0[1]); w.y = pk2(c0[2], c0[3]); w.z = pk2(c1[0], c1[1]); w.w = pk2(c1[2], c1[3]);
                        *(u32x4*)(ckv + (size_t)r_ * 128 + cl) = w;
                        float ss = (c0[0] * c0[0] + c0[1] * c0[1]) + (c0[2] * c0[2] + c0[3] * c0[3]) + (c1[0] * c1[0] + c1[1] * c1[1]) + (c1[2] * c1[2] + c1[3] * c1[3]);
                        ss += __shfl_xor(ss, 16); ss += __shfl_xor(ss, 32);
                        if (fq == 0) __hip_atomic_fetch_add(ckss + r_, rss_enc(ss), __ATOMIC_RELAXED, __HIP_MEMORY_SCOPE_AGENT);
                        if (wc < 2) { const f32x4 k0 = acc[ai][1][m][0] * sc, k1 = acc[ai][1][m][1] * sc;
                            u32x4 wk; wk.x = pk2(k0[0], k0[1]); wk.y = pk2(k0[2], k0[3]); wk.z = pk2(k1[0], k1[1]); wk.w = pk2(k1[2], k1[3]);
                            *(u32x4*)(ik + (size_t)r_ * 64 + cl) = wk; } }
                    asm volatile("" ::: "memory"); }
        }
    }
};
struct EpiBf16Plain {
    static constexpr bool PERM = true, AFTER_DRAIN = false, PROBE2 = true;
    static constexpr int NST = 16;
    bf16* O; int ldc; int cbase; int stacked;
    __device__ __forceinline__ void operator()(const pg8::f32x4 (&acc)[2][2][4][2], const pg8::Unit& u, int wr, int wc, int fr, int fq) const {
        const int pm_ = stacked ? (u.pm & 127) : u.pm, pn_ = stacked ? (u.pn + 4) : u.pn;
        const int row0 = pm_ * 256 + wr * 64 + fr, col0 = cbase + pn_ * 256 + wc * 32 + 8 * fq;
#pragma unroll
        for (int ai = 0; ai < 2; ++ai)
#pragma unroll
            for (int m = 0; m < 4; ++m) { const int r_ = row0 + ai * 128 + m * 16; bf16* rowp = O + (size_t)(r_ >> 8) * (256 * ldc) + (size_t)(col0 >> 6) * (256 * 64) + (size_t)(r_ & 255) * 64 + (col0 & 63);
#pragma unroll
                for (int bj = 0; bj < 2; ++bj) { const f32x4 v0 = acc[ai][bj][m][0], v1 = acc[ai][bj][m][1];
                    u32x4 w; w.x = pk2(v0[0], v0[1]); w.y = pk2(v0[2], v0[3]); w.z = pk2(v1[0], v1[1]); w.w = pk2(v1[2], v1[3]);
                    ST_POL(1, (u32x4*)(rowp + bj * 2 * (256 * 64)), w); } }
    }
};
struct StackOrder {
    pg8::StaticOrder so; int G, c, nbr;
    __device__ void init(int G_, int c_, int nbr_) { so.init(M, DM, G_, c_); G = G_; c = c_; nbr = nbr_; }
    __device__ bool next(int i, pg8::Unit& u) const { const int per = so.nwg / G;   const int bsel = i / per; if (bsel >= nbr) return false; pg8::Unit t; if (!so.next(i - bsel * per, t)) return false; u.pm = 128 * bsel + t.pm; u.pn = 4 * bsel + t.pn; return true; }
    __device__ __forceinline__ void a_ready(const pg8::Unit&) const {}
    __device__ __forceinline__ void done(const pg8::Unit&) const {}
};
struct EpiGateMerge {
    static constexpr bool PERM = false, AFTER_DRAIN = false, PROBE2 = true;
    static constexpr int NST = 32;
    const bf16* P; bf16* mrg; const rss_t* rss; const LAS bf16* bl;
    __device__ __forceinline__ void operator()(const pg8::f32x4 (&acc)[2][2][4][2], const pg8::Unit& u, int wr, int wc, int fr, int fq) const {
        const int row0 = u.pm * 256 + wr * 64 + fr, ch = u.pn * 64 + wc * 16 + fq * 4;
        const bf16* Pt = P + (size_t)u.pm * (256 * 4096) + (size_t)u.pn * (256 * 64) + wc * 16 + fq * 4;
        bf16* Mt = mrg + (size_t)u.pm * (256 * DM) + (size_t)u.pn * (256 * 64) + wc * 16 + fq * 4;
        u32x2 pw[2][4]; rss_t ssn[2];
#pragma unroll
        for (int b4 = 0; b4 < 4; ++b4) pw[0][b4] = *(const u32x2*)(Pt + (size_t)(row0 & 255) * 64 + (size_t)b4 * (16 * 256 * 64));
        ssn[0] = rss[row0];
        asm volatile("" ::: "memory");
#pragma unroll
        for (int g = 0; g < 8; ++g) { const int ai = g >> 2, m = g & 3, r = row0 + ai * 128 + m * 16;
            if (g + 1 < 8) { const int rn = row0 + ((g + 1) >> 2) * 128 + ((g + 1) & 3) * 16; ssn[(g + 1) & 1] = rss[rn];
#pragma unroll
                for (int b4 = 0; b4 < 4; ++b4) pw[(g + 1) & 1][b4] = *(const u32x2*)(Pt + (size_t)(rn & 255) * 64 + (size_t)b4 * (16 * 256 * 64)); }
            const float sc = __builtin_amdgcn_rsqf(rss_dec(ssn[g & 1]) * (1.0f / DM) + EPS); float o0 = 0.f, o1 = 0.f, o2 = 0.f, o3 = 0.f;
#pragma unroll
            for (int bj = 0; bj < 2; ++bj)
#pragma unroll
                for (int n = 0; n < 2; ++n) { const u32x2 pq = pw[g & 1][2 * bj + n]; const u32x2 bw = *(const LAS u32x2*)(bl + (2 * bj + n) * 1024 + ch);
                    const f32x4 a = acc[ai][bj][m][n] * sc + (f32x4){bflo(bw.x), bfhi(bw.x), bflo(bw.y), bfhi(bw.y)};
                    o0 += fsigmoid(a[0]) * bflo(pq.x); o1 += fsigmoid(a[1]) * bfhi(pq.x); o2 += fsigmoid(a[2]) * bflo(pq.y); o3 += fsigmoid(a[3]) * bfhi(pq.y); }
            u32x2 w; w.x = pk2(o0, o1); w.y = pk2(o2, o3);
            ST_POL(2, (u32x2*)(Mt + (size_t)(r & 255) * 64), w); asm volatile("" ::: "memory"); }
    }
};
struct EpiResid {
    static constexpr bool PERM = true, AFTER_DRAIN = false, PROBE2 = false;
    static constexpr int NST = 32;
    bf16* xb; rss_t* rss_out;
    __device__ __forceinline__ void operator()(const pg8::f32x4 (&acc)[2][2][4][2], const pg8::Unit& u, int wr, int wc, int fr, int fq) const {
        const int row0 = u.pm * 256 + wr * 64 + fr, col0 = u.pn * 256 + wc * 32 + 8 * fq;
        u32x4 xin[2][2];
#pragma unroll
        for (int bj = 0; bj < 2; ++bj) xin[0][bj] = *(const u32x4*)(xb + (size_t)row0 * DM + col0 + bj * 128);
        asm volatile("" ::: "memory");
#pragma unroll
        for (int g = 0; g < 8; ++g) { const int ai = g >> 2, m = g & 3, r = row0 + ai * 128 + m * 16; const size_t off = (size_t)r * DM + col0; float ss = 0.f;
            if (g + 1 < 8) { const size_t offn = (size_t)(row0 + ((g + 1) >> 2) * 128 + ((g + 1) & 3) * 16) * DM + col0;
#pragma unroll
                for (int bj = 0; bj < 2; ++bj) xin[(g + 1) & 1][bj] = *(const u32x4*)(xb + offn + bj * 128); }
#pragma unroll
            for (int bj = 0; bj < 2; ++bj) { const u32x4 xw = xin[g & 1][bj];
                const f32x4 v0 = (f32x4){bflo(xw.x), bfhi(xw.x), bflo(xw.y), bfhi(xw.y)} + acc[ai][bj][m][0], v1 = (f32x4){bflo(xw.z), bfhi(xw.z), bflo(xw.w), bfhi(xw.w)} + acc[ai][bj][m][1];
                ss += (v0[0] * v0[0] + v0[1] * v0[1]) + (v0[2] * v0[2] + v0[3] * v0[3]) + (v1[0] * v1[0] + v1[1] * v1[1]) + (v1[2] * v1[2] + v1[3] * v1[3]);
                u32x4 w; w.x = pk2(v0[0], v0[1]); w.y = pk2(v0[2], v0[3]); w.z = pk2(v1[0], v1[1]); w.w = pk2(v1[2], v1[3]); ST_POL(3, (u32x4*)(xb + off + bj * 128), w); }
            ss += __shfl_xor(ss, 16); ss += __shfl_xor(ss, 32);
            if (fq == 0) __hip_atomic_fetch_add(rss_out + r, rss_enc(ss), __ATOMIC_RELAXED, __HIP_MEMORY_SCOPE_AGENT); asm volatile("" ::: "memory"); }
    }
};
struct EpiNull {
    static constexpr bool PERM = true, AFTER_DRAIN = false, PROBE2 = false;
    static constexpr int NST = 0;
    float* sink;
    __device__ __forceinline__ void operator()(const pg8::f32x4 (&acc)[2][2][4][2], const pg8::Unit& u, int wr, int wc, int fr, int fq) const {
        float s = 0.f;
#pragma unroll
        for (int ai = 0; ai < 2; ++ai)
#pragma unroll
            for (int bj = 0; bj < 2; ++bj)
#pragma unroll
                for (int m = 0; m < 4; ++m)
#pragma unroll
                    for (int n = 0; n < 2; ++n) s += acc[ai][bj][m][n][0] + acc[ai][bj][m][n][1] + acc[ai][bj][m][n][2] + acc[ai][bj][m][n][3];
        if (s == 123456.789f) sink[0] = s;
    }
};
struct EpiFF1 {
    static constexpr bool PERM = true, AFTER_DRAIN = false, PROBE2 = true;
    static constexpr int NST = 16;
    bf16* O; const rss_t* rss;
    __device__ __forceinline__ void operator()(const pg8::f32x4 (&acc)[2][2][4][2], const pg8::Unit& u, int wr, int wc, int fr, int fq) const {
        const int row0 = u.pm * 256 + wr * 64 + fr, col0 = u.pn * 256 + wc * 32 + 8 * fq;
        float ssv[8]; rss_t ssr[8];
#pragma unroll
        for (int g = 0; g < 8; ++g) ssr[g] = rss[row0 + (g >> 2) * 128 + (g & 3) * 16];
        asm volatile("" : "+v"(ssr[0]), "+v"(ssr[1]), "+v"(ssr[2]), "+v"(ssr[3]), "+v"(ssr[4]), "+v"(ssr[5]), "+v"(ssr[6]), "+v"(ssr[7]) :: "memory");
#pragma unroll
        for (int g = 0; g < 8; ++g) ssv[g] = rss_dec(ssr[g]);
#pragma unroll
        for (int ai = 0; ai < 2; ++ai)
#pragma unroll
            for (int m = 0; m < 4; ++m) { const int r = row0 + ai * 128 + m * 16; const float sc = __builtin_amdgcn_rsqf(ssv[ai * 4 + m] * (1.0f / DM) + EPS); bf16* rowp = O + (size_t)u.pm * (256 * DFF) + (size_t)(u.pn * 4 + (wc >> 1)) * (256 * 64) + (size_t)(r & 255) * 64 + (wc & 1) * 32 + 8 * fq;
#pragma unroll
                for (int bj = 0; bj < 2; ++bj) { float v[8];
#pragma unroll
                    for (int j = 0; j < 4; ++j) { const float a = fmaxf(acc[ai][bj][m][0][j] * sc, 0.f), b = fmaxf(acc[ai][bj][m][1][j] * sc, 0.f); v[j] = a * a; v[4 + j] = b * b; }
                    u32x4 w; w.x = pk2(v[0], v[1]); w.y = pk2(v[2], v[3]); w.z = pk2(v[4], v[5]); w.w = pk2(v[6], v[7]);
                    ST_POL(4, (u32x4*)(rowp + bj * 2 * (256 * 64)), w); }
                asm volatile("" ::: "memory"); }
    }
};

struct Frame {
    LAS unsigned char* lds;
    int tid, lane, wave, vcu, G;
};
typedef __attribute__((address_space(4))) const unsigned long long kau64;
__device__ __forceinline__ const float* inp(int i) { asm volatile("" : "+s"(i)); kau64* ka = (kau64*)__builtin_amdgcn_kernarg_segment_ptr(); return (const float*)(const GAS float*)ka[i]; }
__device__ __forceinline__ float* outp() { return (float*)inp(30); }
__device__ __forceinline__ unsigned char* wsp() { return (unsigned char*)inp(31); }
#define IN_X 0
#define IN_NORM1 1
#define IN_WIN 2
#define IN_WGATE 3
#define IN_BGATE 4
#define IN_KVG 5
#define IN_WUK 6
#define IN_WUV 7
#define IN_RELB 8
#define IN_WGK2 9
#define IN_BGK 10
#define IN_GLAG 11
#define IN_CONVW 12
#define IN_CONVB 13
#define IN_WRGA 14
#define IN_BRGA 15
#define IN_WRGX 16
#define IN_BRGX 17
#define IN_LAM 18
#define IN_LBP 19
#define IN_HGRNG 20
#define IN_WBRA 21
#define IN_WBRB 22
#define IN_WBRC 23
#define IN_WBRD 24
#define IN_WOUT 25
#define IN_NORM2 26
#define IN_WFF1 27
#define IN_WFF2 28
#define IN_FNORM 29

__device__ __forceinline__ int in_src_col(int n, float& sc) {
    sc = 1.0f;
    const int t = n >> 8, j = n & 255;
    switch (t) {
        case 0: case 1: return -2;
        case 2: return 384 + j;
        case 3: return 708 + j;
        case 4: return 964 + j;
        case 5: return 1220 + j;
        case 6: return 1492 + j;
        case 7: return 2004 + j;
        case 8: return 2260 + j;
        case 9: return 2772 + j;
        case 10: return 3028 + j;
        case 11: if (j < 128) return 256 + j; if (j < 192) return 640 + (j - 128); if (j < 196) return 704 + (j - 192); if (j < 212) return 1476 + (j - 196); return -1;
        case 12: return 1748 + j;
        default: return 2516 + j;
    }
}
__device__ __forceinline__ float in_col_scale(int n) { const int t = n >> 8, j = n & 255; if (t == 3) return 0.125f; if (t == 11 && j >= 192 && j < 196) return 0.0625f; return 1.0f; }
__device__ __forceinline__ int gate_src_col(int n) { const int pn = n >> 8, c = n & 255; const int bj = c >> 7, wc = (c >> 5) & 3, nn = (c >> 4) & 1, fq = (c >> 2) & 3, j = c & 3; return (2 * bj + nn) * 1024 + pn * 64 + wc * 16 + fq * 4 + j; }

template <int MODE>
__device__ __forceinline__ void transpose_item(const float* W, int ldw, int K, int N, const float* g, bf16* WT, LAS float* scr, int item, int lane) {
    const int nblk = N / 32, kb = item / nblk, nb = item % nblk, k0 = 64 * kb, n0 = 32 * nb;
    const int n = n0 + (lane & 31);
    int src; float cs = 1.0f;
    if (MODE == 0) src = n; else if (MODE == 1) { float d; src = in_src_col(n, d); cs = in_col_scale(n); } else src = gate_src_col(n);
    if (MODE == 1 && src == -2) return;
    float tv[32];
#pragma unroll
    for (int i = 0; i < 32; ++i) { const int kk = 2 * i + (lane >> 5); tv[i] = (src >= 0) ? W[(size_t)(k0 + kk) * ldw + src] : 0.f; }
#pragma unroll
    for (int i = 0; i < 32; ++i) { const int kk = 2 * i + (lane >> 5); float v = tv[i] * cs; if (g) v *= g[k0 + kk]; scr[kk * 33 + (lane & 31)] = v; }
    asm volatile("s_waitcnt lgkmcnt(0)" ::: "memory");
    const int c = lane & 7;
#pragma unroll
    for (int j = 0; j < 4; ++j) { const int nn = (lane >> 3) + 8 * j; const LAS float* s = scr + (8 * c) * 33 + nn;
        u32x4 o; o.x = pk2(s[0 * 33], s[1 * 33]); o.y = pk2(s[2 * 33], s[3 * 33]); o.z = pk2(s[4 * 33], s[5 * 33]); o.w = pk2(s[6 * 33], s[7 * 33]);
        *(u32x4*)(WT + (size_t)(n0 + nn) * K + k0 + 8 * c) = o; }
    asm volatile("s_waitcnt lgkmcnt(0)" ::: "memory");
}

__device__ __forceinline__ void phase_prologue(Frame& F) {
    LAS float* scr = (LAS float*)(F.lds + F.wave * 16384);
    const int gw = F.vcu * NWAVES + F.wave, NGW = F.G * NWAVES, lane = F.lane;
    for (int l = 0; l < DEPTH; ++l) {
        unsigned char* wb = wsp() + WS_W + (size_t)l * W_LAYER;
        const float* g1 = inp(IN_NORM1) + l * DM; const float* g2 = inp(IN_NORM2) + l * DM;
        constexpr int I_IN = (DM / 64) * (NIN / 32), I_GATE = (DM / 64) * (4096 / 32), I_BR = (256 / 64) * (DM / 32), I_OUT = (DM / 64) * (DM / 32), I_FF1 = (DM / 64) * (DFF / 32), I_FF2 = (DFF / 64) * (DM / 32);
        constexpr int NIT = I_IN + I_GATE + 3 * I_BR + I_OUT + I_FF1 + I_FF2;
        for (int it = gw; it < NIT; it += NGW) {
            int r = it;
            if (r < I_IN) { transpose_item<1>(inp(IN_WIN) + (size_t)l * DM * IN_COLS, IN_COLS, DM, NIN, g1, (bf16*)(wb + W_IN), scr, r, lane); continue; } r -= I_IN;
            if (r < I_GATE) { transpose_item<2>(inp(IN_WGATE) + (size_t)l * DM * 4096, 4096, DM, 4096, g1, (bf16*)(wb + W_GATE), scr, r, lane); continue; } r -= I_GATE;
            if (r < I_BR) { transpose_item<0>(inp(IN_WBRB) + (size_t)l * 256 * DM, DM, 256, DM, nullptr, (bf16*)(wb + W_BRB), scr, r, lane); continue; } r -= I_BR;
            if (r < I_BR) { transpose_item<0>(inp(IN_WBRC) + (size_t)l * 256 * DM, DM, 256, DM, nullptr, (bf16*)(wb + W_BRC), scr, r, lane); continue; } r -= I_BR;
            if (r < I_BR) { transpose_item<0>(inp(IN_WBRD) + (size_t)l * 256 * DM, DM, 256, DM, nullptr, (bf16*)(wb + W_BRD), scr, r, lane); continue; } r -= I_BR;
            if (r < I_OUT) { transpose_item<0>(inp(IN_WOUT) + (size_t)l * DM * DM, DM, DM, DM, nullptr, (bf16*)(wb + W_OUT), scr, r, lane); continue; } r -= I_OUT;
            if (r < I_FF1) { transpose_item<0>(inp(IN_WFF1) + (size_t)l * DM * DFF, DFF, DM, DFF, g2, (bf16*)(wb + W_FF1), scr, r, lane); continue; } r -= I_FF1;
            transpose_item<0>(inp(IN_WFF2) + (size_t)l * DFF * DM, DM, DFF, DM, nullptr, (bf16*)(wb + W_FF2), scr, r, lane);
        }
        {
            const float* win = inp(IN_WIN) + (size_t)l * DM * IN_COLS; const float* wuk = inp(IN_WUK) + (size_t)l * 4 * 64 * 128; bf16* Wq = (bf16*)(wb + W_IN);
            for (int it = gw; it < 4 * DM; it += NGW) { const int h = it / DM, k = it % DM; float a0 = 0.f, a1 = 0.f;
#pragma unroll 16
                for (int d = 0; d < 64; ++d) { const float w = win[(size_t)k * IN_COLS + h * 64 + d]; a0 += w * wuk[(h * 64 + d) * 128 + lane]; a1 += w * wuk[(h * 64 + d) * 128 + 64 + lane]; }
                const float sc = g1[k] * 0.125f; const float* kvg = inp(IN_KVG) + l * 128;
                Wq[(size_t)(h * 128 + lane) * DM + k] = (bf16)f2bf(a0 * sc * kvg[lane]); Wq[(size_t)(h * 128 + 64 + lane) * DM + k] = (bf16)f2bf(a1 * sc * kvg[64 + lane]); }
        }
        {
            const float* wuv = inp(IN_WUV) + (size_t)l * 4 * 128 * 64; const float* wbr = inp(IN_WBRA) + (size_t)l * 256 * DM; bf16* Wa = (bf16*)(wb + W_BRA);
            for (int it = gw; it < 512 * 16; it += NGW) { const int hc = it / 16, nb = it % 16, h = hc / 128, n = nb * 64 + lane; float a = 0.f;
#pragma unroll 16
                for (int d = 0; d < 64; ++d) a += wuv[(size_t)hc * 64 + d] * wbr[(size_t)(h * 64 + d) * DM + n];
                Wa[(size_t)n * 512 + hc] = (bf16)f2bf(a * inp(IN_KVG)[l * 128 + (hc & 127)]); }
        }
    }
    {
        float* tab = (float*)(wsp() + WS_TAB);
        for (int i = gw * 64 + lane; i < 512; i += NGW * 64) { const int l = i >> 8, c = i & 255; const float p0 = inp(IN_LBP)[c], p1 = inp(IN_LBP)[256 + c];
            const float mx = fmaxf(p0, p1), e0 = expf(p0 - mx), e1 = expf(p1 - mx); const float lb = (l == 0) ? 0.f : e1 / (e0 + e1);
            tab[l * 256 + c] = logf(fmaxf(lb, 1e-20f)); tab[512 + l * 256 + c] = log1pf(-lb); }
    }
    {
        rss_t* rss = (rss_t*)(wsp() + WS_RSS); bf16* xb = (bf16*)(wsp() + WS_XB); const float* x = inp(IN_X);
        for (int i = gw * 64 + lane; i < 4 * M; i += NGW * 64) rss[M + i] = 0ull;
        { rss_t* ckz = (rss_t*)(wsp() + WS_CKSS); for (int i = gw * 64 + lane; i < DEPTH * M; i += NGW * 64) ckz[i] = 0ull; }
        for (int m = gw; m < M; m += 4 * NGW) {
            f32x4 v[4][4];
#pragma unroll
            for (int u = 0; u < 4; ++u) { const f32x4* xr = (const f32x4*)(x + (size_t)(m + u * NGW) * DM) + lane;
#pragma unroll
                for (int j = 0; j < 4; ++j) v[u][j] = xr[64 * j]; }
#pragma unroll
            for (int u = 0; u < 4; ++u) { u32x2* o = (u32x2*)(xb + (size_t)(m + u * NGW) * DM) + lane; float ss = 0.f;
#pragma unroll
                for (int j = 0; j < 4; ++j) { const f32x4 t = v[u][j]; ss += (t[0] * t[0] + t[1] * t[1]) + (t[2] * t[2] + t[3] * t[3]); u32x2 w; w.x = pk2(t[0], t[1]); w.y = pk2(t[2], t[3]); o[64 * j] = w; }
                ss = wave_sum(ss); if (lane == 0) rss[m + u * NGW] = rss_enc(ss); } }
    }
}

__device__ __forceinline__ void phase_prep(Frame& F, int l) {
    const int gw = F.vcu * NWAVES + F.wave, NGW = F.G * NWAVES, lane = F.lane;
    const float* a32 = (const float*)(wsp() + WS_A32); bf16* ckv = (bf16*)(wsp() + WS_CKV); bf16* ik = (bf16*)(wsp() + WS_IK); bf16* ckvt = (bf16*)(wsp() + WS_CKVT);
    const float g0 = inp(IN_KVG)[l * 128 + 2 * lane], g1 = inp(IN_KVG)[l * 128 + 2 * lane + 1];
    for (int m0 = gw; m0 < M; m0 += 4 * NGW) {
        f32x2 vv[4]; float ikv[4];
#pragma unroll
        for (int u = 0; u < 4; ++u) { const float* r = a32 + (size_t)(m0 + u * NGW) * A32_LD; vv[u] = *(const f32x2*)(r + C_CKV + 2 * lane); ikv[u] = r[C_IK + lane]; }
#pragma unroll
        for (int u = 0; u < 4; ++u) { const int m = m0 + u * NGW; const f32x2 v = vv[u];
            const float ss = wave_sum(v.x * v.x + v.y * v.y), rs = 1.0f / sqrtf(ss * (1.0f / 128.f) + EPS);
            const unsigned cw = pk2(v.x * rs * g0, v.y * rs * g1);
            *(unsigned*)(ckv + (size_t)m * 128 + 2 * lane) = cw;
            { const int bb = m / SEQ, k = m % SEQ, kk = k & 31, pp = (k & ~31) + 8 * ((kk >> 2) & 3) + 4 * (kk >> 4) + (kk & 3);
              ckvt[((size_t)bb * 128 + 2 * lane) * SEQ + pp] = (bf16)(cw & 0xffffu); ckvt[((size_t)bb * 128 + 2 * lane + 1) * SEQ + pp] = (bf16)(cw >> 16); }
            ik[(size_t)m * 64 + lane] = (bf16)f2bf(ikv[u]); } }
}

typedef short bf16x8 __attribute__((ext_vector_type(8)));
union Frag { bf16x8 v; unsigned u[4]; u32x4 q; };
__device__ __forceinline__ unsigned cvtpk(float lo, float hi) { return pk2(lo, hi); }
__device__ __forceinline__ f32x4 mfma16(const Frag& a, const Frag& b, f32x4 c) { return __builtin_amdgcn_mfma_f32_16x16x32_bf16(a.v, b.v, c, 0, 0, 0); }
__device__ __forceinline__ float fexp(float x) { return __builtin_amdgcn_exp2f(1.44269504f * x); }
constexpr int GL_QM = 0, GL_KM = 9216, GL_QD = 18432, GL_KD = 27648, GL_QS = 36864, GL_KTT = 46080, GL_VT = 55296, GL_ST0 = 64512, GL_ST1 = 73728, GL_TOT = 82944, GL_SS = 84992, GL_DL = 85504;
struct GlaRaw { unsigned short q[8], k[8], v[8], gt[8]; float g[8]; f32x2 lr; };
__device__ __forceinline__ void gla_load_raw(GlaRaw& R, int mixer, const bf16* a16, const float* a32, int t0, int h, int d, int seg, int lane) {
    { const int r_ = lane & 15, qd_ = lane >> 4, I_ = seg & 3, vh_ = seg >> 2, cg_ = (mixer == 0 ? C_BR : C_DG) + h * 64;
#pragma unroll
      for (int j = 0; j < 4; ++j)
#pragma unroll
          for (int nbi = 0; nbi < 2; ++nbi) R.gt[2 * j + nbi] = a16[(size_t)(t0 + 16 * I_ + 4 * qd_ + j) * A16_LD + cg_ + 16 * (2 * vh_ + nbi) + r_]; }
#pragma unroll
    for (int i = 0; i < 8; ++i) { const size_t row = (size_t)(t0 + 8 * seg + i);
        if (mixer == 0) { R.q[i] = a16[row * A16_LD + C_BQ + h * 64 + d]; R.k[i] = a16[row * A16_LD + C_BK + h * 64 + d]; R.v[i] = a16[row * A16_LD + C_BV + h * 64 + d]; R.g[i] = 0.f; }
        else { R.q[i] = a16[row * A16_LD + C_DQ + h * 64 + d]; R.k[i] = 0; R.v[i] = a16[row * A16_LD + C_DI + h * 64 + d]; R.g[i] = bf2f(a16[row * A16_LD + C_DF + h * 64 + d]); } }
    if (mixer == 0) R.lr = *(const f32x2*)(a32 + (size_t)(t0 + 8 * seg + (lane >> 3)) * A32_LD + C_LR + 2 * (lane & 7)); else R.lr = (f32x2){0.f, 0.f};
}
__device__ __forceinline__ void gla_chain(LAS unsigned char* lds, int tid, int l, int mixer, int b, int h) {
    const int lane = tid & 63, wave = __builtin_amdgcn_readfirstlane(tid >> 6), d = lane, seg = wave;
    const int r = lane & 15, qd = lane >> 4, I = wave & 3, vh = wave >> 2;
    unsigned char* ws = wsp();
    const bf16* a16 = (const bf16*)(ws + WS_A16); const float* a32 = (const float*)(ws + WS_A32);
    bf16* Y = (bf16*)(ws + (mixer == 0 ? WS_YB : WS_YD));
    const float* gn = inp(mixer == 0 ? IN_GLAG : IN_HGRNG) + l * 64;
    LAS float* TOT = (LAS float*)(lds + GL_TOT); LAS float* SS = (LAS float*)(lds + GL_SS); LAS float* DL = (LAS float*)(lds + GL_DL);
    float wg[16]; float bg = 0.f;
#pragma unroll
    for (int rr = 0; rr < 16; ++rr) wg[rr] = (mixer == 0) ? inp(IN_WGK2)[(size_t)l * 4096 + rr * 256 + h * 64 + d] : 0.f;
    if (mixer == 0) bg = inp(IN_BGK)[l * 256 + h * 64 + d];
    for (int i = tid; i < 9216 / 4; i += 512) ((LAS unsigned*)(lds + GL_ST0))[i] = 0u;
    f32x4 Sreg[2] = {{0.f, 0.f, 0.f, 0.f}, {0.f, 0.f, 0.f, 0.f}};
    GlaRaw cur; gla_load_raw(cur, mixer, a16, a32, b * SEQ, h, d, seg, lane);
    for (int c = 0; c < 64; ++c) {
        const int t0 = b * SEQ + c * 64;
        LAS unsigned char* STc = lds + ((c & 1) ? GL_ST1 : GL_ST0); LAS unsigned char* STn = lds + ((c & 1) ? GL_ST0 : GL_ST1);
        float kf[8], p[8];
#pragma unroll
        for (int i = 0; i < 8; ++i) { float gi;
            if (mixer == 0) { float z = bg;
#pragma unroll
                for (int rr = 0; rr < 16; ++rr) { const int lsel = (rr & 1) ? __float_as_int(cur.lr.y) : __float_as_int(cur.lr.x); z += __int_as_float(__builtin_amdgcn_readlane(lsel, 8 * i + (rr >> 1))) * wg[rr]; }
                gi = flogsigmoid(z) * 0.0625f; kf[i] = bf2f(cur.k[i]); }
            else { gi = cur.g[i]; const float eg = fexp(gi); kf[i] = (gi > -0.03125f) ? -gi * (1.0f + gi * (0.5f + gi * (0.16666667f + gi * 0.041666667f))) : 1.0f - eg; }
            p[i] = (i == 0) ? gi : p[i - 1] + gi; }
        TOT[seg * 64 + d] = p[7];
        __syncthreads();
        { float off = 0.f, bl = 0.f, rmid = 0.f, rI = 0.f;
#pragma unroll
          for (int s = 0; s < 8; ++s) { const float tv = TOT[s * 64 + d]; bl += tv; if (s < seg) off += tv; if (s < 4) rmid += tv; if (s < (seg & ~1)) rI += tv; }
          Frag kt, vt; float ktv[8];
#pragma unroll
          for (int i = 0; i < 8; ++i) { const float bb = off + p[i], qv = bf2f(cur.q[i]), kv = kf[i]; const int o = (8 * seg + i) * 72 + d;
              ((LAS unsigned short*)(lds + GL_QM))[o] = (unsigned short)f2bf(qv * fexp(bb - rmid)); ((LAS unsigned short*)(lds + GL_KM))[o] = (unsigned short)f2bf(kv * fexp(rmid - bb));
              ((LAS unsigned short*)(lds + GL_QD))[o] = (unsigned short)f2bf(qv * fexp(bb - rI)); ((LAS unsigned short*)(lds + GL_KD))[o] = (unsigned short)f2bf(kv * fexp(rI - bb));
              ((LAS unsigned short*)(lds + GL_QS))[o] = (unsigned short)f2bf(qv * fexp(bb));
              ktv[i] = kv * fexp(bl - bb); }
#pragma unroll
          for (int i = 0; i < 8; i += 2) { kt.u[i >> 1] = cvtpk(ktv[i], ktv[i + 1]); vt.u[i >> 1] = (unsigned)cur.v[i] | ((unsigned)cur.v[i + 1] << 16); }
          *(LAS u32x4*)(lds + GL_KTT + (d * 72 + 8 * seg) * 2) = kt.q; *(LAS u32x4*)(lds + GL_VT + (d * 72 + 8 * seg) * 2) = vt.q;
          if (seg == 0) DL[d] = fexp(bl); }
        __syncthreads();
        GlaRaw nxt; if (c < 63) gla_load_raw(nxt, mixer, a16, a32, t0 + 64, h, d, seg, lane); else nxt = cur;
        f32x4 o[2] = {{0.f, 0.f, 0.f, 0.f}, {0.f, 0.f, 0.f, 0.f}};
        unsigned P[4][2];
        { Frag qd_[2], qm_[2];
#pragma unroll
          for (int ks = 0; ks < 2; ++ks) { qd_[ks].q = *(const LAS u32x4*)(lds + GL_QD + ((16 * I + r) * 72 + 8 * qd + 32 * ks) * 2); qm_[ks].q = *(const LAS u32x4*)(lds + GL_QM + ((16 * I + r) * 72 + 8 * qd + 32 * ks) * 2); }
#pragma unroll
          for (int J = 0; J < 4; ++J) { P[J][0] = 0u; P[J][1] = 0u;
              if (J <= I) { f32x4 cacc = {0.f, 0.f, 0.f, 0.f};
                  if (J == I) {
#pragma unroll
                      for (int ks = 0; ks < 2; ++ks) { Frag a; a.q = *(const LAS u32x4*)(lds + GL_KD + ((16 * J + r) * 72 + 8 * qd + 32 * ks) * 2); cacc = mfma16(a, qd_[ks], cacc); }
#pragma unroll
                      for (int j = 0; j < 4; ++j) if (4 * qd + j > r) cacc[j] = 0.f;
                  } else {
#pragma unroll
                      for (int ks = 0; ks < 2; ++ks) { Frag a; a.q = *(const LAS u32x4*)(lds + GL_KM + ((16 * J + r) * 72 + 8 * qd + 32 * ks) * 2); cacc = mfma16(a, qm_[ks], cacc); } }
                  P[J][0] = cvtpk(cacc[0], cacc[1]); P[J][1] = cvtpk(cacc[2], cacc[3]); } } }
#pragma unroll
        for (int pr = 0; pr < 2; ++pr) { if (2 * pr <= I) { Frag a; a.u[0] = P[2 * pr][0]; a.u[1] = P[2 * pr][1]; a.u[2] = P[2 * pr + 1][0]; a.u[3] = P[2 * pr + 1][1];
#pragma unroll
            for (int nbi = 0; nbi < 2; ++nbi) { const int nb = 2 * vh + nbi; Frag bb;
                const u32x2 v0 = *(const LAS u32x2*)(lds + GL_VT + ((16 * nb + r) * 72 + 32 * pr + 4 * qd) * 2), v1 = *(const LAS u32x2*)(lds + GL_VT + ((16 * nb + r) * 72 + 32 * pr + 16 + 4 * qd) * 2);
                bb.u[0] = v0.x; bb.u[1] = v0.y; bb.u[2] = v1.x; bb.u[3] = v1.y;
                o[nbi] = mfma16(a, bb, o[nbi]); } } }
#pragma unroll
        for (int ks = 0; ks < 2; ++ks) { Frag qs; qs.q = *(const LAS u32x4*)(lds + GL_QS + ((16 * I + r) * 72 + 8 * qd + 32 * ks) * 2);
#pragma unroll
            for (int nbi = 0; nbi < 2; ++nbi) { const int nb = 2 * vh + nbi; Frag bb; bb.q = *(const LAS u32x4*)(STc + ((16 * nb + r) * 72 + 8 * qd + 32 * ks) * 2); o[nbi] = mfma16(qs, bb, o[nbi]); } }
        { float s4[4];
#pragma unroll
          for (int j = 0; j < 4; ++j) { s4[j] = o[0][j] * o[0][j] + o[1][j] * o[1][j]; s4[j] += __shfl_xor(s4[j], 1); s4[j] += __shfl_xor(s4[j], 2); s4[j] += __shfl_xor(s4[j], 4); s4[j] += __shfl_xor(s4[j], 8); }
          if (r == 0) {
#pragma unroll
              for (int j = 0; j < 4; ++j) SS[vh * 64 + 16 * I + 4 * qd + j] = s4[j]; } }
        { const int db = wave >> 1;
          const f32x4 dlv = *(const LAS f32x4*)(DL + 16 * db + 4 * qd);
#pragma unroll
          for (int nbi = 0; nbi < 2; ++nbi) { const int nb = 2 * (wave & 1) + nbi; f32x4 cacc = Sreg[nbi] * dlv;
#pragma unroll
              for (int ks = 0; ks < 2; ++ks) { Frag a, bb; a.q = *(const LAS u32x4*)(lds + GL_KTT + ((16 * db + r) * 72 + 8 * qd + 32 * ks) * 2); bb.q = *(const LAS u32x4*)(lds + GL_VT + ((16 * nb + r) * 72 + 8 * qd + 32 * ks) * 2); cacc = mfma16(a, bb, cacc); }
              Sreg[nbi] = cacc;
              u32x2 w; w.x = cvtpk(cacc[0], cacc[1]); w.y = cvtpk(cacc[2], cacc[3]);
              *(LAS u32x2*)(STn + ((16 * nb + r) * 72 + 16 * db + 4 * qd) * 2) = w; } }
        __syncthreads();
#pragma unroll
        for (int j = 0; j < 4; ++j) { const int il = 16 * I + 4 * qd + j; const float rs = __builtin_amdgcn_rsqf((SS[il] + SS[64 + il]) * (1.0f / 64.f) + EPS); const size_t row = (size_t)(t0 + il);
#pragma unroll
            for (int nbi = 0; nbi < 2; ++nbi) { const int v = 16 * (2 * vh + nbi) + r; const float gate = bf2f(cur.gt[2 * j + nbi]);
                Y[row * 256 + h * 64 + v] = (bf16)f2bf(o[nbi][j] * rs * gn[v] * gate); } }
        cur = nxt;
    }
    __syncthreads();
}

constexpr int RG_XCB = 0, RG_WAT = 9216, RG_WXT = 18432, RG_AF = 27648, RG_IF = 44032, RG_SEGA = 60416, RG_SEGH = 62464, RG_CARRY = 64512;
__device__ __forceinline__ void rglru_chain(LAS unsigned char* lds, int tid, int l, int b, int blk) {
    const int lane = tid & 63, wave = __builtin_amdgcn_readfirstlane(tid >> 6), ch = lane, seg = wave, gc = blk * 64 + ch;
    const int r = lane & 15, qd = lane >> 4, mb = wave & 3, nh = wave >> 2;
    unsigned char* ws = wsp();
    const bf16* a16 = (const bf16*)(ws + WS_A16); const float* a32 = (const float*)(ws + WS_A32); bf16* Y = (bf16*)(ws + WS_YC);
    LAS float* AF = (LAS float*)(lds + RG_AF); LAS float* IFm = (LAS float*)(lds + RG_IF); LAS float* SEGA = (LAS float*)(lds + RG_SEGA); LAS float* SEGH = (LAS float*)(lds + RG_SEGH); LAS float* CARRY = (LAS float*)(lds + RG_CARRY);
    { const float* wa = inp(IN_WRGA) + ((size_t)l * 4 + blk) * 4096; const float* wx = inp(IN_WRGX) + ((size_t)l * 4 + blk) * 4096;
      for (int e = tid; e < 4096; e += 512) { const int i = e >> 6, j = e & 63; ((LAS unsigned short*)(lds + RG_WAT))[j * 72 + i] = (unsigned short)f2bf(wa[e]); ((LAS unsigned short*)(lds + RG_WXT))[j * 72 + i] = (unsigned short)f2bf(wx[e]); }
      if (tid < 128) CARRY[tid] = 0.f; }
    float cw[4];
#pragma unroll
    for (int j = 0; j < 4; ++j) cw[j] = inp(IN_CONVW)[l * 1024 + j * 256 + gc];
    const float cb = inp(IN_CONVB)[l * 256 + gc];
    float ba2[2], bx2[2], sp2[2];
#pragma unroll
    for (int nbi = 0; nbi < 2; ++nbi) { const int j = blk * 64 + 16 * (2 * nh + nbi) + r; ba2[nbi] = inp(IN_BRGA)[l * 256 + j]; bx2[nbi] = inp(IN_BRGX)[l * 256 + j];
        const float nl = -inp(IN_LAM)[l * 256 + j]; sp2[nbi] = fmaxf(nl, 0.f) + log1pf(expf(-fabsf(nl))); }
    __syncthreads();
    float xn[11]; unsigned short cyn[8];
#define RG_LOAD(c_) do { const int tl_ = (c_) * 64 + 8 * seg; _Pragma("unroll") for (int i = 0; i < 11; ++i) { const int t = tl_ - 3 + i; xn[i] = (t >= 0) ? bf2f(a16[(size_t)(b * SEQ + t) * A16_LD + C_CX + gc]) : 0.f; } \
        _Pragma("unroll") for (int i = 0; i < 8; ++i) cyn[i] = a16[(size_t)(b * SEQ + tl_ + i) * A16_LD + C_CY + gc]; } while (0)
    RG_LOAD(0);
    for (int c = 0; c < 64; ++c) {
        const int tl0 = c * 64 + 8 * seg;
        float x[11], xc[8]; unsigned short cy[8];
#pragma unroll
        for (int i = 0; i < 11; ++i) x[i] = xn[i];
#pragma unroll
        for (int i = 0; i < 8; ++i) cy[i] = cyn[i];
        if (c < 63) RG_LOAD(c + 1);
#pragma unroll
        for (int i = 0; i < 8; ++i) { xc[i] = cb + cw[0] * x[i] + cw[1] * x[i + 1] + cw[2] * x[i + 2] + cw[3] * x[i + 3]; ((LAS unsigned short*)(lds + RG_XCB))[(8 * seg + i) * 72 + ch] = (unsigned short)f2bf(xc[i]); }
        __syncthreads();
#pragma unroll
        for (int nbi = 0; nbi < 2; ++nbi) { const int nb = 2 * nh + nbi; f32x4 za = {0.f, 0.f, 0.f, 0.f}, zx = {0.f, 0.f, 0.f, 0.f};
#pragma unroll
            for (int ks = 0; ks < 2; ++ks) { Frag a, wa, wx; a.q = *(const LAS u32x4*)(lds + RG_XCB + ((16 * mb + r) * 72 + 8 * qd + 32 * ks) * 2);
                wa.q = *(const LAS u32x4*)(lds + RG_WAT + ((16 * nb + r) * 72 + 8 * qd + 32 * ks) * 2); wx.q = *(const LAS u32x4*)(lds + RG_WXT + ((16 * nb + r) * 72 + 8 * qd + 32 * ks) * 2);
                za = mfma16(a, wa, za); zx = mfma16(a, wx, zx); }
#pragma unroll
            for (int j = 0; j < 4; ++j) { const int t = 16 * mb + 4 * qd + j; const float rg = fsigmoid(za[j] + ba2[nbi]), ig = fsigmoid(zx[j] + bx2[nbi]); const float la = -8.0f * rg * sp2[nbi];
                const float ea = fexp(la), y2 = 2.0f * la; const float om = (y2 > -0.25f) ? -y2 * (1.0f + y2 * (0.5f + y2 * (0.16666667f + y2 * (0.041666667f + y2 * 0.0083333333f)))) : 1.0f - ea * ea;
                AF[t * 64 + 16 * nb + r] = ea; IFm[t * 64 + 16 * nb + r] = __builtin_amdgcn_sqrtf(fmaxf(om, 0.f)) * ig; } }
        __syncthreads();
        float hl[8], al[8]; { float H = 0.f, A = 1.f;
#pragma unroll
          for (int i = 0; i < 8; ++i) { const float a = AF[(8 * seg + i) * 64 + ch], u = IFm[(8 * seg + i) * 64 + ch] * xc[i]; H = a * H + u; A *= a; hl[i] = H; al[i] = A; }
          SEGA[seg * 64 + ch] = A; SEGH[seg * 64 + ch] = H; }
        __syncthreads();
        float hin = CARRY[(c & 1) * 64 + ch];
#pragma unroll
        for (int s = 0; s < 7; ++s) if (s < seg) hin = SEGA[s * 64 + ch] * hin + SEGH[s * 64 + ch];
        float hlast = 0.f;
#pragma unroll
        for (int i = 0; i < 8; ++i) { const float hv = hl[i] + al[i] * hin; hlast = hv; const size_t row = (size_t)(b * SEQ + tl0 + i);
            Y[row * 256 + gc] = (bf16)f2bf(hv * bf2f(cy[i])); }
        if (seg == 7) CARRY[((c + 1) & 1) * 64 + ch] = hlast;
    }
    __syncthreads();
}
__device__ __forceinline__ int t5_bucket(int n) {
    if (n < 16) return n;
    int b = 16;
    b += (n >= 19) + (n >= 21) + (n >= 24) + (n >= 27) + (n >= 31) + (n >= 35) + (n >= 40) + (n >= 46) + (n >= 52) + (n >= 59) + (n >= 67) + (n >= 77) + (n >= 87) + (n >= 99) + (n >= 113);
    return b;
}

#ifndef DSA_SPARSE
#define DSA_SPARSE 1
#endif
constexpr int HP = 257;
constexpr int DS_H = 0;
constexpr int SP = 130;
constexpr int DS_SEL = 49920;
constexpr int DS_TIE = 33280;
constexpr int DS_H2 = 66560;
constexpr int DS_BUF0 = 66560, DS_BUF1 = 0;
constexpr int DS_KTB = 17408, DS_STG = 35840;
constexpr int WREG = 10752;
constexpr int DS_LUT = 66560 + 4 * WREG;
constexpr int DS_QS = DS_LUT + 2048;
constexpr int DS_ITEM = DS_QS + 1024;
constexpr int DS_RSK = DS_ITEM + 64;
constexpr int CW_QUEUE = 8192;
__device__ __forceinline__ float relu_i(float x) { const int b = __float_as_int(x); return __int_as_float(b > 0 ? b : 0); }
__device__ __forceinline__ unsigned key16(float s) {
    s = s + 0.0f;
    const _Float16 hf = (_Float16)s; unsigned short hb = __builtin_bit_cast(unsigned short, hf);
    return (hb & 0x8000u) ? (unsigned)(hb ^ 0xFFFFu) : (unsigned)(hb | 0x8000u);
}
typedef _Float16 f16x2_t __attribute__((ext_vector_type(2)));
typedef short s16x2_t __attribute__((ext_vector_type(2)));
__device__ __forceinline__ unsigned keys2(float a, float b) {
    const f16x2_t hv = {(_Float16)a, (_Float16)b}; const unsigned h = __builtin_bit_cast(unsigned, hv);
    const s16x2_t sg = __builtin_bit_cast(s16x2_t, h) >> 15;
    return h ^ (__builtin_bit_cast(unsigned, sg) | 0x80008000u);
}
__device__ __forceinline__ unsigned wave_suffix_sum(unsigned v, int lane) {
    unsigned s = v;
    s += (unsigned)__builtin_amdgcn_update_dpp(0, (int)s, 0x101, 0xf, 0xf, true);
    s += (unsigned)__builtin_amdgcn_update_dpp(0, (int)s, 0x102, 0xf, 0xf, true);
    s += (unsigned)__builtin_amdgcn_update_dpp(0, (int)s, 0x104, 0xf, 0xf, true);
    s += (unsigned)__builtin_amdgcn_update_dpp(0, (int)s, 0x108, 0xf, 0xf, true);
    const unsigned t1 = (unsigned)__builtin_amdgcn_readlane((int)s, 16), t2 = (unsigned)__builtin_amdgcn_readlane((int)s, 32), t3 = (unsigned)__builtin_amdgcn_readlane((int)s, 48);
    const int row = lane >> 4;
    return s + (row == 0 ? t1 + t2 + t3 : (row == 1 ? t2 + t3 : (row == 2 ? t3 : 0u)));
}
__device__ __forceinline__ void dsa_find_bin(const LAS unsigned* hrow, int lane, unsigned need, unsigned& B, unsigned& above, unsigned& atB) {
    u32x4 c4;
    c4.x = hrow[4 * lane] + hrow[HP + 4 * lane]; c4.y = hrow[4 * lane + 1] + hrow[HP + 4 * lane + 1]; c4.z = hrow[4 * lane + 2] + hrow[HP + 4 * lane + 2]; c4.w = hrow[4 * lane + 3] + hrow[HP + 4 * lane + 3];
    const unsigned tot = c4.x + c4.y + c4.z + c4.w, suf = wave_suffix_sum(tot, lane);
    const unsigned excl = suf - tot;
    const bool mine = (suf >= need) && (excl < need);
    unsigned b = 0, ab = 0, at = 0;
    if (mine) { unsigned acc = excl; const unsigned cc[4] = {c4.x, c4.y, c4.z, c4.w};
#pragma unroll
        for (int k = 3; k >= 0; --k) { if (acc < need && acc + cc[k] >= need) { b = 4 * lane + k; ab = acc; at = cc[k]; } acc += cc[k]; } }
    const unsigned long long mm = __ballot(mine); const int src = mm ? (int)__builtin_ctzll(mm) : 0;
    B = (unsigned)__builtin_amdgcn_readlane((int)b, src); above = (unsigned)__builtin_amdgcn_readlane((int)ab, src); atB = (unsigned)__builtin_amdgcn_readlane((int)at, src);
}
__device__ __forceinline__ void dsa_select16(LAS unsigned char* lds, const bf16* ikb, const bf16* a16, const float* a32, size_t q0h, int p0h, int half, int NT, int tid) {
    const int lane = tid & 63, wave = __builtin_amdgcn_readfirstlane(tid >> 6), r = lane & 15, qd = lane >> 4;
    LAS unsigned* H = (LAS unsigned*)(lds + DS_H); LAS unsigned* SEL = (LAS unsigned*)(lds + DS_SEL) + half * 16 * SP; LAS unsigned* TIE = (LAS unsigned*)(lds + DS_TIE) + half * 16 * SP; LAS unsigned* QS = (LAS unsigned*)(lds + DS_QS);
    LAS unsigned* Hme = H + (r * 2 + (qd & 1)) * HP;
    LAS unsigned* H2 = (LAS unsigned*)(lds + DS_H2); LAS unsigned* Hme2 = H2 + (r * 2 + (qd & 1)) * HP;
    const int pos = p0h + r;
    const int nrem = NT - wave;
    const int lim = pos - (16 * wave + 4 * qd);
    LAS unsigned* SELw = SEL + r * SP + (wave >> 1); LAS unsigned* TIEw = TIE + r * SP + (wave >> 1); const int shw = 16 * (wave & 1) + 4 * qd;
    unsigned KR[32][2];
    {
        Frag BQ[4][2]; float wq[4];
        { const size_t row = q0h + r;
#pragma unroll
          for (int h = 0; h < 4; ++h) { wq[h] = a32[row * A32_LD + C_IW + h];
#pragma unroll
              for (int ks = 0; ks < 2; ++ks) BQ[h][ks].q = *(const u32x4*)(a16 + row * A16_LD + C_IQ + h * 64 + 8 * qd + 32 * ks); } }
        Frag an[3][2];
        const bf16* pa = ikb + (size_t)(16 * wave + r) * 64 + 8 * qd;
#pragma unroll
        for (int pf = 0; pf < 3; ++pf) { if (8 * pf < nrem) {
#pragma unroll
            for (int ks = 0; ks < 2; ++ks) an[pf][ks].q = *(const u32x4*)(pa + (size_t)pf * (8 * 16 * 64) + 32 * ks); } }
#pragma unroll
        for (int it = 0; it < 32; ++it) { KR[it][0] = 0u; KR[it][1] = 0u;
            if (8 * it < nrem) {
                Frag a[2]; a[0] = an[it % 3][0]; a[1] = an[it % 3][1];
                if (8 * (it + 3) < nrem) { unsigned eo = (unsigned)(it + 3) * (8 * 16 * 64); asm volatile("" : "+v"(eo));
#pragma unroll
                  for (int ks = 0; ks < 2; ++ks) an[it % 3][ks].q = *(const u32x4*)(pa + eo + 32 * ks); }
                f32x4 sc = {0.f, 0.f, 0.f, 0.f};
#pragma unroll
                for (int h = 0; h < 4; ++h) { f32x4 acc = {0.f, 0.f, 0.f, 0.f}; acc = mfma16(a[0], BQ[h][0], acc); acc = mfma16(a[1], BQ[h][1], acc);
#pragma unroll
                    for (int j = 0; j < 4; ++j) sc[j] += wq[h] * relu_i(acc[j]); }
                unsigned k01 = keys2(sc[0], sc[1]), k23 = keys2(sc[2], sc[3]);
                if (128 * it + 16 * wave + 15 > p0h) { const int dd = lim - 128 * it;
                    k01 &= (dd >= 1) ? 0xFFFFFFFFu : (dd >= 0 ? 0xFFFFu : 0u); k23 &= (dd >= 3) ? 0xFFFFFFFFu : (dd >= 2 ? 0xFFFFu : 0u); }
                __hip_atomic_fetch_add(Hme + ((k01 >> 8) & 255u), 1u, __ATOMIC_RELAXED, __HIP_MEMORY_SCOPE_WORKGROUP); __hip_atomic_fetch_add(Hme + (k01 >> 24), 1u, __ATOMIC_RELAXED, __HIP_MEMORY_SCOPE_WORKGROUP);
                __hip_atomic_fetch_add(Hme + ((k23 >> 8) & 255u), 1u, __ATOMIC_RELAXED, __HIP_MEMORY_SCOPE_WORKGROUP); __hip_atomic_fetch_add(Hme + (k23 >> 24), 1u, __ATOMIC_RELAXED, __HIP_MEMORY_SCOPE_WORKGROUP);
                KR[it][0] = k01; KR[it][1] = k23; } }
    }
    __syncthreads();
#pragma unroll 1
    for (int qi = wave * 2; qi < wave * 2 + 2; ++qi) { unsigned B, ab, at; dsa_find_bin(H + qi * 2 * HP, lane, (unsigned)TOPK, B, ab, at); if (lane == 0) { QS[qi] = B; QS[32 + qi] = ab; } }
    __syncthreads();
    { const unsigned b1 = QS[r];
#pragma unroll
      for (int it = 0; it < 32; ++it) { if (8 * it < nrem) { const unsigned kw[2] = {KR[it][0], KR[it][1]};
#pragma unroll
          for (int j = 0; j < 4; ++j) { const unsigned k = (kw[j >> 1] >> (16 * (j & 1))) & 0xffffu; if ((k >> 8) == b1) __hip_atomic_fetch_add(Hme2 + (k & 255u), 1u, __ATOMIC_RELAXED, __HIP_MEMORY_SCOPE_WORKGROUP); } } }
      for (int i = tid; i < 32 * HP / 4; i += 512) ((LAS u32x4*)(lds + DS_H))[i] = (u32x4){0u, 0u, 0u, 0u}; }
    __syncthreads();
#pragma unroll 1
    for (int qi = wave * 2; qi < wave * 2 + 2; ++qi) { const unsigned ab1 = QS[32 + qi], b1q = QS[qi]; unsigned B, ab, at; dsa_find_bin(H2 + qi * 2 * HP, lane, (unsigned)TOPK - ab1, B, ab, at);
        if (lane == 0) { const unsigned rt = (unsigned)TOPK - ab1 - ab; QS[64 + qi] = (b1q << 8) | B; QS[96 + qi] = rt; QS[128 + qi] = (at == rt) ? 1u : 0u; } }
    __syncthreads();
    { const unsigned tau = QS[64 + r]; const bool allt = QS[128 + r] != 0u;
#pragma unroll
      for (int it = 0; it < 32; ++it) { if (8 * it < nrem) { unsigned selb = 0u, tieb = 0u; const unsigned kw[2] = {KR[it][0], KR[it][1]};
#pragma unroll
          for (int j = 0; j < 4; ++j) { const unsigned k = (kw[j >> 1] >> (16 * (j & 1))) & 0xffffu; const bool gt = k > tau, eq = (k == tau); const bool s1 = gt | (eq & allt); selb |= (s1 ? 1u : 0u) << j; tieb |= ((eq && !s1) ? 1u : 0u) << j; }
          __hip_atomic_fetch_or(SELw + 4 * it, selb << shw, __ATOMIC_RELAXED, __HIP_MEMORY_SCOPE_WORKGROUP); if (tieb) __hip_atomic_fetch_or(TIEw + 4 * it, tieb << shw, __ATOMIC_RELAXED, __HIP_MEMORY_SCOPE_WORKGROUP); } }
      for (int i = tid; i < 32 * HP / 4; i += 512) ((LAS u32x4*)(lds + DS_H2))[i] = (u32x4){0u, 0u, 0u, 0u}; }
    __syncthreads();
#pragma unroll 1
    for (int qi = wave * 2; qi < wave * 2 + 2; ++qi) { if (QS[128 + qi] == 0u) { const unsigned rem = QS[96 + qi];
        unsigned w0 = TIE[qi * SP + 2 * lane], w1 = TIE[qi * SP + 2 * lane + 1]; const unsigned c0 = __popc(w0), c1 = __popc(w1);
        unsigned pre = c0 + c1;
#pragma unroll
        for (int o = 1; o < 64; o <<= 1) { const unsigned t = __shfl_up(pre, o); if (lane >= o) pre += t; }
        unsigned before = pre - (c0 + c1);
        if (before < rem && (c0 + c1) != 0u) { unsigned quota = rem - before;
            unsigned k0 = 0u; { unsigned bits = w0; while (bits && quota) { const unsigned lowb = bits & (0u - bits); k0 |= lowb; bits ^= lowb; --quota; } }
            unsigned k1 = 0u; { unsigned bits = w1; while (bits && quota) { const unsigned lowb = bits & (0u - bits); k1 |= lowb; bits ^= lowb; --quota; } }
            if (k0) SEL[qi * SP + 2 * lane] |= k0; if (k1) SEL[qi * SP + 2 * lane + 1] |= k1; } } }
    __syncthreads();
}

typedef short s16x4 __attribute__((ext_vector_type(4)));
__device__ __forceinline__ u32x2 lds_tr16(const LAS unsigned char* p) { const s16x4 v = __builtin_amdgcn_ds_read_tr16_b64_v4i16((LAS s16x4*)p); return __builtin_bit_cast(u32x2, v); }
__device__ __forceinline__ void dsa_sparse_query(LAS unsigned char* wl, const LAS unsigned* selrow, const LAS float* LUT, const bf16* ckv, const rss_t* ckss, const bf16* a16, bf16* olat, size_t row, int pos, int lane) {
    const int r = lane & 15, qd = lane >> 4;
    LAS unsigned char* G = wl; LAS unsigned short* IDX = (LAS unsigned short*)(wl + 8704); LAS unsigned short* IDX2 = (LAS unsigned short*)(wl + 9216); LAS float* RSQ = (LAS float*)(wl + 9728);
    { unsigned w0 = selrow[2 * lane], w1 = selrow[2 * lane + 1]; const int cnt = __popc(w0) + __popc(w1); int pre = cnt;
#pragma unroll
      for (int o = 1; o < 64; o <<= 1) { const int t = __shfl_up(pre, o); if (lane >= o) pre += t; }
      int p = pre - cnt;
      while (w0) { const int bpos = __builtin_ctz(w0); w0 &= w0 - 1u; if (p < TOPK) { const unsigned short kv_ = (unsigned short)(64 * lane + bpos); IDX[p] = kv_; IDX2[(p & ~31) + 8 * (p & 3) + ((p & 31) >> 2)] = kv_; } ++p; }
      while (w1) { const int bpos = __builtin_ctz(w1); w1 &= w1 - 1u; if (p < TOPK) { const unsigned short kv_ = (unsigned short)(64 * lane + 32 + bpos); IDX[p] = kv_; IDX2[(p & ~31) + 8 * (p & 3) + ((p & 31) >> 2)] = kv_; } ++p; } }
    asm volatile("s_waitcnt lgkmcnt(0)" ::: "memory");
#pragma unroll
    for (int i = 0; i < 4; ++i) { const int p_ = lane + 64 * i; const unsigned key_ = IDX[p_]; RSQ[p_] = __builtin_amdgcn_rsqf(rss_dec(ckss[key_]) * (1.0f / 128.f) + EPS) * 1.44269504f; }
    Frag qf[4];
#pragma unroll
    for (int ks = 0; ks < 4; ++ks) { qf[ks].q = (u32x4){0u, 0u, 0u, 0u}; if (r < 4) qf[ks].q = *(const u32x4*)(a16 + row * A16_LD + C_QL + r * 128 + 8 * qd + 32 * ks); }
    f32x4 O[8];
#pragma unroll
    for (int mb = 0; mb < 8; ++mb) O[mb] = (f32x4){0.f, 0.f, 0.f, 0.f};
    float mrun = -1e30f, lsum = 0.f;
    u32x4 gA[8], gB[8];
#define SP_GATHER(G_, c_) do { const u32x4 kq_ = *(const LAS u32x4*)(IDX2 + 32 * (c_) + 8 * (lane >> 4)); const unsigned kk_[4] = {kq_.x, kq_.y, kq_.z, kq_.w}; \
        _Pragma("unroll") for (int i_ = 0; i_ < 8; ++i_) { const unsigned key_ = (kk_[i_ >> 1] >> (16 * (i_ & 1))) & 0xffffu; G_[i_] = *(const u32x4*)(ckv + (size_t)key_ * 128 + 8 * (lane & 15)); } } while (0)
    asm volatile("s_waitcnt lgkmcnt(0)" ::: "memory");
    SP_GATHER(gA, 0); SP_GATHER(gB, 1);
#pragma unroll 1
    for (int c2 = 0; c2 < 8; c2 += 2)
#pragma unroll
    for (int cc = 0; cc < 2; ++cc) { const int c = c2 + cc;
#pragma unroll
        for (int i = 0; i < 8; ++i) { const int pc = lane + 64 * i; *(LAS u32x4*)(G + ((pc >> 4) * 136 + 8 * (pc & 15)) * 2) = cc ? gB[i] : gA[i]; }
        if (c + 2 < 8) { if (cc) SP_GATHER(gB, c + 2); else SP_GATHER(gA, c + 2); }
        const u32x2 kw0 = *(const LAS u32x2*)(IDX + 32 * c + 4 * qd), kw1 = *(const LAS u32x2*)(IDX + 32 * c + 16 + 4 * qd);
        f32x4 S[2];
#pragma unroll
        for (int T = 0; T < 2; ++T) { Frag ak[4]; S[T] = (f32x4){0.f, 0.f, 0.f, 0.f};
#pragma unroll
            for (int ks = 0; ks < 4; ++ks) ak[ks].q = *(const LAS u32x4*)(G + ((16 * T + r) * 136 + 8 * qd + 32 * ks) * 2);
#pragma unroll
            for (int ks = 0; ks < 4; ++ks) S[T] = mfma16(ak[ks], qf[ks], S[T]); }
        float l2[8]; float mx = -1e30f; float rsl[8];
        { const f32x4 ra = *(const LAS f32x4*)(RSQ + 32 * c + 4 * qd), rb = *(const LAS f32x4*)(RSQ + 32 * c + 16 + 4 * qd);
#pragma unroll
          for (int j = 0; j < 4; ++j) { rsl[j] = ra[j]; rsl[4 + j] = rb[j]; } }
        { const unsigned kk[4] = {kw0.x, kw0.y, kw1.x, kw1.y};
#pragma unroll
          for (int e = 0; e < 8; ++e) { const int key = (int)((kk[e >> 1] >> (16 * (e & 1))) & 0xffffu); int dist = pos - key; dist = dist < 0 ? 0 : (dist > 127 ? 127 : dist);
              const float v = S[e >> 2][e & 3] * rsl[e] + LUT[dist * 4 + (r & 3)]; l2[e] = v; mx = fmaxf(mx, v); } }
        mx = fmaxf(mx, __shfl_xor(mx, 16)); mx = fmaxf(mx, __shfl_xor(mx, 32));
        const float mnew = (mx > mrun + 6.0f) ? mx : mrun, alpha = __builtin_amdgcn_exp2f(mrun - mnew); mrun = mnew;
        float pv[8]; float ps = 0.f;
#pragma unroll
        for (int e = 0; e < 8; ++e) { pv[e] = __builtin_amdgcn_exp2f(l2[e] - mnew); ps += pv[e]; }
        lsum = lsum * alpha + ps;
        const bool resc = __any(alpha != 1.0f);
#pragma unroll
        for (int e = 0; e < 8; ++e) pv[e] *= rsl[e] * 0.69314718f;
        Frag pb; pb.u[0] = pk2(pv[0], pv[1]); pb.u[1] = pk2(pv[2], pv[3]); pb.u[2] = pk2(pv[4], pv[5]); pb.u[3] = pk2(pv[6], pv[7]);
#pragma unroll
        for (int m4 = 0; m4 < 8; m4 += 4) { Frag av[4];
#pragma unroll
            for (int mi = 0; mi < 4; ++mi) { const int mb = m4 + mi; const u32x2 t0 = lds_tr16(G + ((4 * qd + (r >> 2)) * 136 + 16 * mb + 4 * (r & 3)) * 2), t1 = lds_tr16(G + ((16 + 4 * qd + (r >> 2)) * 136 + 16 * mb + 4 * (r & 3)) * 2);
                av[mi].u[0] = t0.x; av[mi].u[1] = t0.y; av[mi].u[2] = t1.x; av[mi].u[3] = t1.y; }
#pragma unroll
            for (int mi = 0; mi < 4; ++mi) { if (resc) O[m4 + mi] = O[m4 + mi] * alpha; O[m4 + mi] = mfma16(av[mi], pb, O[m4 + mi]); } }
        asm volatile("s_waitcnt lgkmcnt(0)" ::: "memory");
    }
#undef SP_GATHER
    lsum += __shfl_xor(lsum, 16); lsum += __shfl_xor(lsum, 32);
    const float inv = 1.0f / lsum;
    if (r < 4) {
#pragma unroll
        for (int mb = 0; mb < 8; ++mb) { u32x2 w; w.x = pk2(O[mb][0] * inv, O[mb][1] * inv); w.y = pk2(O[mb][2] * inv, O[mb][3] * inv);
            *(u32x2*)(olat + row * 512 + r * 128 + 16 * mb + 4 * qd) = w; } }
}
__device__ __forceinline__ void dsa_process_item(LAS unsigned char* lds, int tid_in, int l, int b, int qt) {
    int tid = tid_in; asm volatile("" : "+v"(tid));
    const int lane = tid & 63, wave = __builtin_amdgcn_readfirstlane(tid >> 6), r = lane & 15, qd = lane >> 4;
    unsigned char* ws = wsp();
    const bf16* a16 = (const bf16*)(ws + WS_A16); const float* a32 = (const float*)(ws + WS_A32);
    const bf16* ckv = (const bf16*)(ws + WS_CKV) + (size_t)b * SEQ * 128; const rss_t* ckss = (const rss_t*)(ws + WS_CKSS) + (size_t)l * M + (size_t)b * SEQ; const bf16* ikb = (const bf16*)(ws + WS_IK) + (size_t)b * SEQ * 64;
    bf16* olat = (bf16*)(ws + WS_OLAT);
    const int p0 = qt * 32; const size_t q0 = (size_t)b * SEQ + p0;
    LAS unsigned* H = (LAS unsigned*)(lds + DS_H); LAS unsigned* SEL = (LAS unsigned*)(lds + DS_SEL); LAS unsigned* TIE = (LAS unsigned*)(lds + DS_TIE); LAS unsigned* QS = (LAS unsigned*)(lds + DS_QS);
    LAS float* LUT = (LAS float*)(lds + DS_LUT);
    for (int i = tid; i < 66560 / 16; i += 512) ((LAS u32x4*)(lds + DS_H))[i] = (u32x4){0u, 0u, 0u, 0u};
    if (p0 >= TOPK) for (int i = tid; i < 32 * HP / 4; i += 512) ((LAS u32x4*)(lds + DS_H2))[i] = (u32x4){0u, 0u, 0u, 0u};
    __syncthreads();
    const int NT = p0 / 16 + 2;
    if (p0 < TOPK) {
        for (int i = tid; i < 32 * 128; i += 512) { const int q = i >> 7, w = i & 127, pos = p0 + q; const int lo = 32 * w; unsigned bits = 0u;
            if (pos >= lo + 31) bits = 0xFFFFFFFFu; else if (pos >= lo) bits = (2u << (pos - lo)) - 1u;
            SEL[q * SP + w] = bits; }
        __syncthreads();
    } else {
#pragma unroll 1
        for (int half = 0; half < 2; ++half) dsa_select16(lds, ikb, a16, a32, q0 + 16 * half, p0 + 16 * half, half, NT, tid);
    }
    if (tid < 128) { const int bk = t5_bucket(tid);
#pragma unroll
        for (int hh = 0; hh < 4; ++hh) LUT[tid * 4 + hh] = inp(IN_RELB)[bk * 4 + hh] * 1.44269504f; }
#if DSA_SPARSE
    if (p0 >= 2048) {
        __syncthreads();
        LAS unsigned char* wl = lds + (wave < 4 ? wave * WREG : 66560 + (wave - 4) * WREG);
#pragma unroll 1
#ifdef PROBE_SP2
        for (int qi = 0; qi < 4; ++qi) { const int qq = wave * 4 + qi; dsa_sparse_query(wl, SEL + qq * SP, LUT, ckv, ckss, a16, olat, q0 + qq, p0 + qq, lane); }
#endif
        for (int qi = 0; qi < 4; ++qi) { const int qq = wave * 4 + qi; dsa_sparse_query(wl, SEL + qq * SP, LUT, ckv, ckss, a16, olat, q0 + qq, p0 + qq, lane); }
    } else
#endif
    {
        const int h = wave & 3, qh = wave >> 2, qq = 16 * qh + r; const int pos = p0 + qq; const size_t row = q0 + qq;
        Frag bq[4];
#pragma unroll
        for (int ks = 0; ks < 4; ++ks) bq[ks].q = *(const u32x4*)(a16 + row * A16_LD + C_QL + h * 128 + 8 * qd + 32 * ks);
        const float bfar = inp(IN_RELB)[31 * 4 + h] * 1.44269504f;
        f32x4 O[8];
#pragma unroll
        for (int mb = 0; mb < 8; ++mb) O[mb] = (f32x4){0.f, 0.f, 0.f, 0.f};
        float mrun = -1e30f, lsum = 0.f;
        const int NS = p0 / 64 + 1;
        LAS float* RSK = (LAS float*)(lds + DS_RSK);
        for (int k_ = tid; k_ < 64 * NS; k_ += 512) RSK[k_] = __builtin_amdgcn_rsqf(rss_dec(ckss[k_ < SEQ ? k_ : SEQ - 1]) * (1.0f / 128.f) + EPS) * 1.44269504f;
        u32x4 kreg[2];
#define DSA_LOAD(s_) do { _Pragma("unroll") for (int i_ = 0; i_ < 2; ++i_) { const int c_ = tid + 512 * i_; \
            int kr_ = 64 * (s_) + (c_ >> 4); kr_ = kr_ < SEQ ? kr_ : SEQ - 1; kreg[i_] = *(const u32x4*)(ckv + (size_t)kr_ * 128 + 8 * (c_ & 15)); } } while (0)
#define DSA_STORE(base_) do { _Pragma("unroll") for (int i_ = 0; i_ < 2; ++i_) { const int c_ = tid + 512 * i_; \
            *(LAS u32x4*)((base_) + ((c_ >> 4) * 136 + 8 * (c_ & 15)) * 2) = kreg[i_]; } } while (0)
#ifdef PROBE_DSA_ATT2
        for (int rp_ = 0; rp_ < 2; ++rp_) { mrun = -1e30f; lsum = 0.f;
#pragma unroll
        for (int mb = 0; mb < 8; ++mb) O[mb] = (f32x4){0.f, 0.f, 0.f, 0.f};
#endif
        DSA_LOAD(0); DSA_STORE(lds + DS_BUF0);
        __syncthreads();
#pragma unroll 1
        for (int s = 0; s < NS; ++s) {
            LAS unsigned char* cb_ = lds + ((s & 1) ? DS_BUF1 : DS_BUF0); LAS unsigned char* nb_ = lds + ((s & 1) ? DS_BUF0 : DS_BUF1);
            if (s + 1 < NS) DSA_LOAD(s + 1);
            const LAS unsigned char* KT = cb_;
            f32x4 S[4];
#pragma unroll
            for (int T = 0; T < 4; ++T) { S[T] = (f32x4){0.f, 0.f, 0.f, 0.f}; Frag ak[4];
#pragma unroll
                for (int ks = 0; ks < 4; ++ks) ak[ks].q = *(const LAS u32x4*)(KT + ((16 * T + r) * 136 + 8 * qd + 32 * ks) * 2);
#pragma unroll
                for (int ks = 0; ks < 4; ++ks) S[T] = mfma16(ak[ks], bq[ks], S[T]); }
            const unsigned sw0 = SEL[qq * SP + 2 * s], sw1 = (2 * s + 1 < 128) ? SEL[qq * SP + 2 * s + 1] : 0u;
            const bool far = (p0 - (64 * s + 63)) >= 113;
            float l2[16]; float mx = -1e30f;
            f32x4 rsk[4];
#pragma unroll
            for (int T = 0; T < 4; ++T) rsk[T] = *(const LAS f32x4*)(RSK + 64 * s + 16 * T + 4 * qd);
            float bias[16];
#pragma unroll
            for (int e = 0; e < 16; ++e) bias[e] = bfar;
            if (!far) {
#pragma unroll
                for (int T = 0; T < 4; ++T)
#pragma unroll
                    for (int j = 0; j < 4; ++j) { int dist = pos - (64 * s + 16 * T + 4 * qd + j); dist = dist < 0 ? 0 : (dist > 127 ? 127 : dist); bias[4 * T + j] = LUT[dist * 4 + h]; } }
#pragma unroll
            for (int T = 0; T < 4; ++T) { const unsigned nib = (((T & 2) ? sw1 : sw0) >> (16 * (T & 1) + 4 * qd)) & 15u;
#pragma unroll
                for (int j = 0; j < 4; ++j) { const float v = (nib & (1u << j)) ? (S[T][j] * rsk[T][j] + bias[4 * T + j]) : -1e30f; l2[4 * T + j] = v; mx = fmaxf(mx, v); } }
            mx = fmaxf(mx, __shfl_xor(mx, 16)); mx = fmaxf(mx, __shfl_xor(mx, 32));
            const float mnew = (mx > mrun + 6.0f) ? mx : mrun, alpha = __builtin_amdgcn_exp2f(mrun - mnew); mrun = mnew;
            float ps = 0.f; Frag pb[2];
#pragma unroll
            for (int u = 0; u < 2; ++u) { float pv[8];
#pragma unroll
                for (int j = 0; j < 8; ++j) { const float v = l2[8 * u + j]; pv[j] = (v > -1e29f) ? __builtin_amdgcn_exp2f(v - mnew) : 0.f; ps += pv[j]; }
#pragma unroll
                for (int j = 0; j < 8; ++j) pv[j] *= rsk[2 * u + (j >> 2)][j & 3] * 0.69314718f;
                pb[u].u[0] = pk2(pv[0], pv[1]); pb[u].u[1] = pk2(pv[2], pv[3]); pb[u].u[2] = pk2(pv[4], pv[5]); pb[u].u[3] = pk2(pv[6], pv[7]); }
            lsum = lsum * alpha + ps;
            if (__any(alpha != 1.0f)) {
#pragma unroll
                for (int mb = 0; mb < 8; ++mb) O[mb] = O[mb] * alpha; }
#pragma unroll
            for (int mb = 0; mb < 8; ++mb)
#pragma unroll
                for (int u = 0; u < 2; ++u) { Frag a; const u32x2 t0 = lds_tr16(KT + ((32 * u + 4 * qd + (r >> 2)) * 136 + 16 * mb + 4 * (r & 3)) * 2), t1 = lds_tr16(KT + ((32 * u + 16 + 4 * qd + (r >> 2)) * 136 + 16 * mb + 4 * (r & 3)) * 2);
                    a.u[0] = t0.x; a.u[1] = t0.y; a.u[2] = t1.x; a.u[3] = t1.y; O[mb] = mfma16(a, pb[u], O[mb]); }
            if (s + 1 < NS) DSA_STORE(nb_);
            __syncthreads();
        }
#ifdef PROBE_DSA_ATT2
        }
#endif
#undef DSA_LOAD
#undef DSA_STORE
        lsum += __shfl_xor(lsum, 16); lsum += __shfl_xor(lsum, 32);
        const float inv = 1.0f / lsum;
#pragma unroll
        for (int mb = 0; mb < 8; ++mb) { u32x2 w; w.x = pk2(O[mb][0] * inv, O[mb][1] * inv); w.y = pk2(O[mb][2] * inv, O[mb][3] * inv);
            *(u32x2*)(olat + row * 512 + h * 128 + 16 * mb + 4 * qd) = w; }
    }
    __syncthreads();
}
__device__ __forceinline__ void dsa_worker(LAS unsigned char* lds, int tid, int lq) {
    const int l = lq & 1;
    unsigned* ctl = (unsigned*)(wsp() + WS_CTL);
    const unsigned myx = xb_xcc_id() & 7u;
    LAS unsigned* ITEM = (LAS unsigned*)(lds + DS_ITEM);
#pragma unroll 1
    for (unsigned qs = 0; qs < 8; ++qs) { const unsigned bq = (myx + qs) & 7u;
#pragma unroll 1
        for (;;) {
            if (tid == 0) ITEM[0] = __hip_atomic_fetch_add(ctl + CW_QUEUE + (lq * 8 + (int)bq) * 64, 1u, __ATOMIC_RELAXED, __HIP_MEMORY_SCOPE_AGENT);
            __syncthreads();
            const unsigned id = ITEM[0];
            __syncthreads();
            if (id >= 128u) break;
            dsa_process_item(lds, tid, l, (int)bq, 127 - (int)id);
        }
    }
}

#ifndef MIX_DSA_OPT
#define MIX_DSA_OPT 1
#endif
#ifndef MIX_CHAINS
#define MIX_CHAINS 7
#endif
__device__ __forceinline__ void naive_gla(Frame& F, int l, int mixer, int b, int h) {
    LAS float* Q = (LAS float*)F.lds; LAS float* K = Q + 4096; LAS float* V = K + 4096; LAS float* Bc = V + 4096; LAS float* S = Bc + 4096; LAS float* AT = S + 4096; LAS float* QE = AT + 4096; LAS float* KT = QE + 4096;
    const int tid = F.tid;
    const bf16* a16 = (const bf16*)(wsp() + WS_A16); const float* a32 = (const float*)(wsp() + WS_A32);
    bf16* Y = (bf16*)(wsp() + (mixer == 0 ? WS_YB : WS_YD));
    const float* gn = inp(mixer == 0 ? IN_GLAG : IN_HGRNG) + l * 64;
    const float* wgk2 = inp(IN_WGK2) + (size_t)l * 16 * 256; const float* bgk = inp(IN_BGK) + l * 256;
    for (int i = 0; i < 8; ++i) S[tid + 512 * i] = 0.f;
    __syncthreads();
    for (int c = 0; c < 64; ++c) {
        const int t0 = b * SEQ + c * 64;
#pragma unroll 1
        for (int i = 0; i < 8; ++i) { const int e = tid + 512 * i, tt = e >> 6, d = e & 63; const size_t row = (size_t)(t0 + tt);
            float q, k, v, g;
            if (mixer == 0) {
                q = bf2f(a16[row * A16_LD + C_BQ + h * 64 + d]); k = bf2f(a16[row * A16_LD + C_BK + h * 64 + d]); v = bf2f(a16[row * A16_LD + C_BV + h * 64 + d]);
                float z = bgk[h * 64 + d];
#pragma unroll 4
                for (int r = 0; r < 16; ++r) z += a32[row * A32_LD + C_LR + r] * wgk2[r * 256 + h * 64 + d];
                g = (fminf(z, 0.f) - log1pf(expf(-fabsf(z)))) * (1.0f / 16.0f);
            } else {
                q = bf2f(a16[row * A16_LD + C_DQ + h * 64 + d]); const float lf = bf2f(a16[row * A16_LD + C_DF + h * 64 + d]); k = -expm1f(lf); v = bf2f(a16[row * A16_LD + C_DI + h * 64 + d]); g = lf;
            }
            Q[e] = q; K[e] = k; V[e] = v; Bc[e] = g; }
        __syncthreads();
        if (tid < 64) { float run = 0.f; for (int tt = 0; tt < 64; ++tt) { run += Bc[tt * 64 + tid]; Bc[tt * 64 + tid] = run; } }
        __syncthreads();
#pragma unroll 1
        for (int i = 0; i < 8; ++i) { const int e = tid + 512 * i, ii = e >> 6, jj = e & 63; float a = 0.f;
            if (jj <= ii) for (int d = 0; d < 64; ++d) a += Q[ii * 64 + d] * K[jj * 64 + d] * __expf(Bc[ii * 64 + d] - Bc[jj * 64 + d]);
            AT[e] = a;
            const int d2 = e & 63, t2 = e >> 6; QE[e] = Q[e] * __expf(Bc[e]); KT[e] = K[e] * __expf(Bc[63 * 64 + d2] - Bc[t2 * 64 + d2]); }
        __syncthreads();
#pragma unroll 1
        for (int i = 0; i < 8; ++i) { const int e = tid + 512 * i, ii = e >> 6, vv = e & 63; float a = 0.f;
#pragma unroll 2
            for (int j = 0; j <= ii; ++j) a += AT[ii * 64 + j] * V[j * 64 + vv];
#pragma unroll 2
            for (int d = 0; d < 64; ++d) a += QE[ii * 64 + d] * S[d * 64 + vv];
            asm volatile("s_waitcnt lgkmcnt(0)" ::: "memory");
            AT[e] = a; }
        __syncthreads();
#pragma unroll 1
        for (int i = 0; i < 8; ++i) { const int e = tid + 512 * i, d = e >> 6, vv = e & 63;
            float a = __expf(Bc[63 * 64 + d]) * S[e];
#pragma unroll 2
            for (int j = 0; j < 64; ++j) a += KT[j * 64 + d] * V[j * 64 + vv];
            S[e] = a; }
        __syncthreads();
#pragma unroll 1
        for (int i = 0; i < 8; ++i) { const int e = tid + 512 * i, ii = e >> 6, vv = e & 63; float ss = 0.f;
            for (int v2 = 0; v2 < 64; ++v2) ss += AT[ii * 64 + v2] * AT[ii * 64 + v2];
            const float rs = 1.0f / sqrtf(ss * (1.0f / 64.f) + EPS); const size_t row = (size_t)(t0 + ii);
            const float gate = bf2f(a16[row * A16_LD + (mixer == 0 ? C_BR : C_DG) + h * 64 + vv]);
            Y[row * 256 + h * 64 + vv] = (bf16)f2bf(AT[e] * rs * gn[vv] * gate); }
        __syncthreads();
    }
}
__device__ __forceinline__ void naive_rglru(Frame& F, int l, int b, int blk) {
    LAS float* XC = (LAS float*)F.lds; LAS float* AA = XC + 4096; LAS float* UU = AA + 4096; LAS float* HH = UU + 4096;
    const int tid = F.tid;
    const bf16* a16 = (const bf16*)(wsp() + WS_A16); const float* a32 = (const float*)(wsp() + WS_A32); bf16* Y = (bf16*)(wsp() + WS_YC);
    const float* cw = inp(IN_CONVW) + l * 4 * 256; const float* cb = inp(IN_CONVB) + l * 256;
    const float* wa = inp(IN_WRGA) + ((size_t)l * 4 + blk) * 4096; const float* ba = inp(IN_BRGA) + l * 256 + blk * 64;
    const float* wx = inp(IN_WRGX) + ((size_t)l * 4 + blk) * 4096; const float* bx = inp(IN_BRGX) + l * 256 + blk * 64;
    const float* lam = inp(IN_LAM) + l * 256 + blk * 64;
    float hcur = 0.f;
    for (int c = 0; c < 64; ++c) {
        const int t0 = c * 64;
#pragma unroll 1
        for (int i = 0; i < 8; ++i) { const int e = tid + 512 * i, tt = e >> 6, ch = e & 63, t = t0 + tt, gc = blk * 64 + ch; float a = cb[gc];
            for (int j = 0; j < 4; ++j) { const int ts = t - 3 + j; if (ts >= 0) a += cw[j * 256 + gc] * bf2f(a16[(size_t)(b * SEQ + ts) * A16_LD + C_CX + gc]); }
            XC[e] = a; }
        __syncthreads();
#pragma unroll 1
        for (int i = 0; i < 8; ++i) { const int e = tid + 512 * i, tt = e >> 6, j = e & 63; float za = ba[j], zx = bx[j];
#pragma unroll 4
            for (int k = 0; k < 64; ++k) { const float x = XC[tt * 64 + k]; za += x * wa[k * 64 + j]; zx += x * wx[k * 64 + j]; }
            const float r = 1.0f / (1.0f + expf(-za)), ig = 1.0f / (1.0f + expf(-zx));
            const float nl = -lam[j]; const float sp = fmaxf(nl, 0.f) + log1pf(expf(-fabsf(nl)));
            const float la = -8.0f * r * sp;
            AA[e] = expf(la); UU[e] = sqrtf(fmaxf(-expm1f(2.0f * la), 0.f)) * (ig * XC[e]); }
        __syncthreads();
        if (tid < 64) { for (int tt = 0; tt < 64; ++tt) { hcur = AA[tt * 64 + tid] * hcur + UU[tt * 64 + tid]; HH[tt * 64 + tid] = hcur; } }
        __syncthreads();
#pragma unroll 1
        for (int i = 0; i < 8; ++i) { const int e = tid + 512 * i, tt = e >> 6, ch = e & 63; const size_t row = (size_t)(b * SEQ + t0 + tt);
            Y[row * 256 + blk * 64 + ch] = (bf16)f2bf(HH[e] * bf2f(a16[row * A16_LD + C_CY + blk * 64 + ch])); }
        __syncthreads();
    }
}
__device__ __forceinline__ void naive_dsa(Frame& F, int l, int wg, int nwg) {
    LAS unsigned short* KEYS = (LAS unsigned short*)F.lds;
    LAS unsigned char* wbase = F.lds + 65536 + F.wave * 8192;
    LAS float* IQs = (LAS float*)wbase;
    LAS float* QLs = IQs + 256;
    LAS unsigned short* IDX = (LAS unsigned short*)(QLs + 512);
    LAS float* Ps = (LAS float*)(wbase + 3584);
    LAS unsigned short* myk = KEYS + F.wave * 4096;
    const int lane = F.lane;
    const bf16* a16 = (const bf16*)(wsp() + WS_A16); const float* a32 = (const float*)(wsp() + WS_A32);
    const bf16* ckv = (const bf16*)(wsp() + WS_CKV); const bf16* ikb = (const bf16*)(wsp() + WS_IK); bf16* olat = (bf16*)(wsp() + WS_OLAT);
    const float* relb = inp(IN_RELB);
    for (int it = wg; it < M / 8; it += nwg) {
        const int row = it * 8 + F.wave, b = row / SEQ, pos = row % SEQ, n = pos + 1;
        const size_t brow = (size_t)b * SEQ;
        for (int i = lane; i < 256; i += 64) IQs[i] = bf2f(a16[(size_t)row * A16_LD + C_IQ + i]);
        for (int i = lane; i < 512; i += 64) QLs[i] = bf2f(a16[(size_t)row * A16_LD + C_QL + i]);
        const float w0 = a32[(size_t)row * A32_LD + C_IW + 0], w1 = a32[(size_t)row * A32_LD + C_IW + 1], w2 = a32[(size_t)row * A32_LD + C_IW + 2], w3 = a32[(size_t)row * A32_LD + C_IW + 3];
        asm volatile("s_waitcnt lgkmcnt(0)" ::: "memory");
#pragma unroll 1
        for (int s0 = 0; s0 < n; s0 += 64) { const int s = s0 + lane;
            if (s < n) { const u32x4* kr = (const u32x4*)(ikb + (brow + s) * 64); float d0 = 0.f, d1 = 0.f, d2 = 0.f, d3 = 0.f;
#pragma unroll 2
                for (int c8 = 0; c8 < 8; ++c8) { const u32x4 kw = kr[c8]; const unsigned kk[4] = {kw.x, kw.y, kw.z, kw.w};
#pragma unroll
                    for (int j = 0; j < 4; ++j) { const float k0 = bflo(kk[j]), k1 = bfhi(kk[j]); const int d = c8 * 8 + 2 * j;
                        d0 += IQs[d] * k0 + IQs[d + 1] * k1; d1 += IQs[64 + d] * k0 + IQs[64 + d + 1] * k1; d2 += IQs[128 + d] * k0 + IQs[128 + d + 1] * k1; d3 += IQs[192 + d] * k0 + IQs[192 + d + 1] * k1; } }
                const float sc = w0 * fmaxf(d0, 0.f) + w1 * fmaxf(d1, 0.f) + w2 * fmaxf(d2, 0.f) + w3 * fmaxf(d3, 0.f);
                myk[s] = (unsigned short)key16(sc); } }
        asm volatile("s_waitcnt lgkmcnt(0)" ::: "memory");
        unsigned tau = 0; int r = 0;
        if (n > TOPK) {
            for (int bit = 15; bit >= 0; --bit) { const unsigned cand = tau | (1u << bit); int cnt = 0;
                for (int s = lane; s < n; s += 64) cnt += ((unsigned)myk[s] >= cand) ? 1 : 0;
                cnt = wave_isum(cnt); if (cnt >= TOPK) tau = cand; }
            int cg = 0; for (int s = lane; s < n; s += 64) cg += ((unsigned)myk[s] > tau) ? 1 : 0;
            cg = wave_isum(cg); r = TOPK - cg;
        }
        int nsel = 0, ties = 0;
        for (int s0 = 0; s0 < n; s0 += 64) { const int s = s0 + lane; bool gt = false, tie = false;
            if (s < n) { if (n <= TOPK) gt = true; else { const unsigned k = myk[s]; gt = k > tau; tie = (k == tau); } }
            const unsigned long long tb = __ballot(tie); const unsigned long long lt = (1ull << lane) - 1ull;
            const int trank = ties + __popcll(tb & lt); const bool sel = gt || (tie && trank < r);
            const unsigned long long sb = __ballot(sel); const int p = nsel + __popcll(sb & lt);
            if (sel) IDX[p] = (unsigned short)s;
            nsel += __popcll(sb); ties += __popcll(tb); }
        asm volatile("s_waitcnt lgkmcnt(0)" ::: "memory");
        float lg[4][4];
#pragma unroll
        for (int j = 0; j < 4; ++j) { const int kx = j * 64 + lane;
            if (kx < nsel) { const int s = IDX[kx]; const u32x4* cr = (const u32x4*)(ckv + (brow + s) * 128); float d0 = 0.f, d1 = 0.f, d2 = 0.f, d3 = 0.f;
#pragma unroll 2
                for (int c8 = 0; c8 < 16; ++c8) { const u32x4 cw = cr[c8]; const unsigned cc[4] = {cw.x, cw.y, cw.z, cw.w};
#pragma unroll
                    for (int q = 0; q < 4; ++q) { const float c0 = bflo(cc[q]), c1 = bfhi(cc[q]); const int d = c8 * 8 + 2 * q;
                        d0 += QLs[d] * c0 + QLs[d + 1] * c1; d1 += QLs[128 + d] * c0 + QLs[128 + d + 1] * c1; d2 += QLs[256 + d] * c0 + QLs[256 + d + 1] * c1; d3 += QLs[384 + d] * c0 + QLs[384 + d + 1] * c1; } }
                const int bk = t5_bucket(pos - s);
                lg[j][0] = d0 + relb[bk * 4 + 0]; lg[j][1] = d1 + relb[bk * 4 + 1]; lg[j][2] = d2 + relb[bk * 4 + 2]; lg[j][3] = d3 + relb[bk * 4 + 3];
            } else { lg[j][0] = lg[j][1] = lg[j][2] = lg[j][3] = -1e30f; } }
#pragma unroll
        for (int hh = 0; hh < 4; ++hh) { float mx = fmaxf(fmaxf(lg[0][hh], lg[1][hh]), fmaxf(lg[2][hh], lg[3][hh])); mx = wave_max(mx);
            float e[4], sm = 0.f;
#pragma unroll
            for (int j = 0; j < 4; ++j) { e[j] = (j * 64 + lane < nsel) ? __expf(lg[j][hh] - mx) : 0.f; sm += e[j]; }
            sm = wave_sum(sm); const float inv = 1.0f / sm;
#pragma unroll
            for (int j = 0; j < 4; ++j) Ps[hh * 256 + j * 64 + lane] = e[j] * inv; }
        asm volatile("s_waitcnt lgkmcnt(0)" ::: "memory");
        float o[4][2] = {{0.f, 0.f}, {0.f, 0.f}, {0.f, 0.f}, {0.f, 0.f}};
#pragma unroll 2
        for (int kx = 0; kx < nsel; ++kx) { const int s = IDX[kx]; const unsigned cw = *(const unsigned*)(ckv + (brow + s) * 128 + 2 * lane); const float c0 = bflo(cw), c1 = bfhi(cw);
#pragma unroll
            for (int hh = 0; hh < 4; ++hh) { const float p = Ps[hh * 256 + kx]; o[hh][0] += p * c0; o[hh][1] += p * c1; } }
#pragma unroll
        for (int hh = 0; hh < 4; ++hh) *(unsigned*)(olat + (size_t)row * 512 + hh * 128 + 2 * lane) = pk2(o[hh][0], o[hh][1]);
        asm volatile("s_waitcnt lgkmcnt(0)" ::: "memory");
    }
}
__device__ __forceinline__ void phase_mixers_naive(Frame& F, int l, int rep) {
    const int wg = (int)blockIdx.x;
#ifdef PROBE_CHAINS2
    for (int rp_ = 0; rp_ < PROBE_CHAINS2; ++rp_)
#endif
    if (wg < 32) { if (MIX_CHAINS & 1) gla_chain(F.lds, F.tid, l, 0, wg >> 2, wg & 3); else naive_gla(F, l, 0, wg >> 2, wg & 3); }
    else if (wg < 64) { if (MIX_CHAINS & 2) gla_chain(F.lds, F.tid, l, 1, (wg - 32) >> 2, (wg - 32) & 3); else naive_gla(F, l, 1, (wg - 32) >> 2, (wg - 32) & 3); }
    else if (wg < 96) { if (MIX_CHAINS & 4) rglru_chain(F.lds, F.tid, l, (wg - 64) >> 2, (wg - 64) & 3); else naive_rglru(F, l, (wg - 64) >> 2, (wg - 64) & 3); }
#if MIX_DSA_OPT
#ifdef PROBE_REP_CHAINS_ONLY
    if (rep == 0)
#endif
    dsa_worker(F.lds, F.tid, l + 2 * rep);
#else
    else { naive_dsa(F, l, wg - 96, F.G - 96); }
#endif
}
__device__ __forceinline__ void phase_final(Frame& F) {
    const int gw = F.vcu * NWAVES + F.wave, NGW = F.G * NWAVES, lane = F.lane;
    const rss_t* rss = (const rss_t*)(wsp() + WS_RSS) + 4 * (size_t)M; const f32x4* g = (const f32x4*)inp(IN_FNORM) + lane;
    float* outb = outp(); const bf16* xb = (const bf16*)(wsp() + WS_XB);
    for (int m = gw; m < M; m += 4 * NGW) {
        u32x2 v[4][4]; float rsv[4];
#pragma unroll
        for (int u = 0; u < 4; ++u) { rsv[u] = rss_dec(rss[m + u * NGW]); const u32x2* xr = (const u32x2*)(xb + (size_t)(m + u * NGW) * DM) + lane;
#pragma unroll
            for (int j = 0; j < 4; ++j) v[u][j] = xr[64 * j]; }
#pragma unroll
        for (int u = 0; u < 4; ++u) { const float rs = 1.0f / sqrtf(rsv[u] * (1.0f / DM) + EPS); f32x4* xr = (f32x4*)(outb + (size_t)(m + u * NGW) * DM) + lane;
#pragma unroll
            for (int j = 0; j < 4; ++j) { const u32x2 w = v[u][j]; xr[64 * j] = (f32x4){bflo(w.x), bfhi(w.x), bflo(w.y), bfhi(w.y)} * rs * g[64 * j]; } } }
}

#ifndef STAGGER_TICKS
#define STAGGER_TICKS 0
#endif
#ifndef STAGGER_GM
#define STAGGER_GM 3u
#endif
#ifndef STAGGER_SLEEP
#define STAGGER_SLEEP 127
#endif
#define STAGGER() do { if (STAGGER_TICKS) { const unsigned grp_ = (unsigned)__builtin_amdgcn_readfirstlane((int)((blockIdx.x >> 3) & STAGGER_GM)); for (unsigned i_ = 0; i_ < grp_ * (STAGGER_TICKS); ++i_) __builtin_amdgcn_s_sleep(STAGGER_SLEEP); } } while (0)
#ifndef GEMM_SP2
#define GEMM_SP2 true
#endif
#ifndef RELAX_MASK
#define RELAX_MASK 0x00u
#endif
#define RLX(b) (((RELAX_MASK >> (b)) & 1u) != 0u)
#ifndef GEMM_ALIGN_EPI
#define GEMM_ALIGN_EPI true
#endif
#ifndef MK_ONE_LAUNCH
#define MK_ONE_LAUNCH 1
#endif
constexpr int PH_PER_LAYER = 8;
constexpr int N_PHASES = 1 + DEPTH * PH_PER_LAYER + 1;
struct Args { const float* in[30]; float* out; unsigned char* ws; int ph_lo, ph_hi; };
__device__ __forceinline__ int fresh_lane_id() { unsigned ones = ~0u; asm volatile("" : "+s"(ones)); return (int)__builtin_amdgcn_mbcnt_hi(ones, __builtin_amdgcn_mbcnt_lo(ones, 0u)); }
__global__ void __launch_bounds__(NWAVES * 64, 2) hybrid_fwd(Args args) {
    extern __shared__ __attribute__((aligned(16))) unsigned char lds[];
    const int wave_s_ = __builtin_amdgcn_readfirstlane((int)threadIdx.x >> 6);
#define MYTID() (wave_s_ * 64 + fresh_lane_id())
#define MKFRAME Frame F; { int t_ = MYTID(); asm volatile("" : "+v"(t_)); F.lds = (LAS unsigned char*)lds; F.tid = t_; F.lane = t_ & 63; F.wave = __builtin_amdgcn_readfirstlane(t_ >> 6); F.G = gridDim.x; const int bx = blockIdx.x; F.vcu = (F.G % 8 == 0) ? (bx % 8) * (F.G / 8) + bx / 8 : bx; }
    for (int u = threadIdx.x; u < (LDS_BYTES - LDSCTL_OFF) / 4; u += NWAVES * 64) ((LAS unsigned*)((LAS unsigned char*)lds + LDSCTL_OFF))[u] = 0u;
    __syncthreads();
    if (MK_ONE_LAUNCH) (void)xcd_barrier_post((unsigned*)(wsp() + WS_CTL) + CW_BAR, (volatile LAS unsigned*)((LAS unsigned char*)lds + MISC_OFF) + 8);
    const int lo = args.ph_lo, hi = args.ph_hi; (void)lo; (void)hi;
#ifndef PH_MASK
#define PH_MASK 0xFFFFFFFFu
#endif
#if MK_ONE_LAUNCH
#define IN(k) true
#else
#define IN(k) (lo <= (k) && (k) < hi)
#endif
#define EN(b) ((PH_MASK >> (b)) & 1u)
#ifndef REP_MASK
#define REP_MASK 0u
#endif
#define REPS(b) for (int rep_ = 0; rep_ < (int)((REP_MASK >> (b)) & 1u) + 1; ++rep_)
#define SEAM(k) do { if (IN(k) && IN((k) + 1)) { XcdBarrier bar_; bar_.bar = (unsigned*)(wsp() + WS_CTL) + CW_BAR; bar_.x = xb_xcc_id(); bar_.st = (volatile LAS unsigned*)((LAS unsigned char*)lds + MISC_OFF) + 8; xcd_barrier(bar_, wave_s_ == 0 && fresh_lane_id() == 0); } } while (0)
    if (EN(0) && IN(0)) REPS(0) { MKFRAME phase_prologue(F); } SEAM(0);
    for (int l = 0; l < DEPTH; ++l) {
        const int p0 = 1 + l * PH_PER_LAYER;
#define PH_PTRS int gx_ = (int)gridDim.x, bx_ = (int)blockIdx.x; asm volatile("" : "+s"(gx_), "+s"(bx_)); unsigned char* ws = wsp(); unsigned char* wb = ws + WS_W + (size_t)l * W_LAYER; rss_t* rssb = (rss_t*)(ws + WS_RSS); bf16* xb = (bf16*)(ws + WS_XB); (void)wb; (void)rssb; (void)xb;
        if (EN(1) && IN(p0 + 0)) REPS(1) {
            PH_PTRS
            STAGGER();
            pg8::Gemm g{(const pg8::bf16_t*)xb, (const pg8::bf16_t*)(wb + W_IN), M, NIN, DM}; pg8::StaticOrder S; S.init(M, NIN, gx_, bx_);
            LAS float* lbl = (LAS float*)((LAS unsigned char*)lds + LDSCTL_OFF + 1024);
            { const float* tab = (const float*)(ws + WS_TAB); const int t_ = MYTID(); if (t_ < 256) { lbl[t_] = tab[l * 256 + t_]; lbl[256 + t_] = tab[512 + l * 256 + t_]; } }
            __syncthreads();
            EpiInProj E{(bf16*)(ws + WS_A16), (float*)(ws + WS_A32), rssb + (size_t)(2 * l) * M, lbl, lbl + 256, (bf16*)(ws + WS_CKV), (bf16*)(ws + WS_IK), (rss_t*)(ws + WS_CKSS) + (size_t)l * M};
            pg8::gemm_phase<EpiInProj, pg8::StaticOrder, GEMM_ALIGN_EPI, GEMM_SP2, RLX(0)>((PG8_LAS unsigned char*)lds, g, S, E, MYTID());
        } SEAM(p0 + 0);
        if (EN(3) && IN(p0 + 2)) REPS(3) { MKFRAME phase_mixers_naive(F, l, rep_); } SEAM(p0 + 2);
        if (EN(4) && IN(p0 + 3)) REPS(4) {
            STAGGER();
            for (int br = 0; br < 2; ++br) {
                PH_PTRS
                pg8::Gemm g{(const pg8::bf16_t*)(ws + (br ? WS_YB : WS_OLAT)), (const pg8::bf16_t*)(wb + (br ? W_BRB : W_BRA)), M, DM, br ? 256 : 512}; StackOrder S; S.init(gx_, bx_, br ? 3 : 1); EpiBf16Plain E{(bf16*)(ws + WS_P), 4096, 0, br};
                pg8::gemm_phase<EpiBf16Plain, StackOrder, GEMM_ALIGN_EPI, GEMM_SP2, RLX(1)>((PG8_LAS unsigned char*)lds, g, S, E, MYTID());
            }
        } SEAM(p0 + 3);
        if (EN(5) && IN(p0 + 4)) REPS(5) {
            PH_PTRS
            STAGGER();
            pg8::Gemm g{(const pg8::bf16_t*)xb, (const pg8::bf16_t*)(wb + W_GATE), M, 4096, DM}; pg8::StaticOrder S; S.init(M, 4096, gx_, bx_);
            LAS bf16* bl = (LAS bf16*)((LAS unsigned char*)lds + LDSCTL_OFF + 1024);
            { const float* bg = inp(IN_BGATE) + l * 4096; for (int i = MYTID(); i < 4096; i += NWAVES * 64) bl[i] = (bf16)f2bf(bg[i]); }
            __syncthreads();
            EpiGateMerge E{(const bf16*)(ws + WS_P), (bf16*)(ws + WS_MRG), rssb + (size_t)(2 * l) * M, bl};
            pg8::gemm_phase<EpiGateMerge, pg8::StaticOrder, GEMM_ALIGN_EPI, GEMM_SP2, RLX(2)>((PG8_LAS unsigned char*)lds, g, S, E, MYTID());
        } SEAM(p0 + 4);
        if (EN(6) && IN(p0 + 5)) {
            PH_PTRS
            pg8::Gemm g{(const pg8::bf16_t*)(ws + WS_MRG), (const pg8::bf16_t*)(wb + W_OUT), M, DM, DM, 1}; pg8::StaticOrder S; S.init(M, DM, gx_, bx_);
            EpiResid E{xb, rssb + (size_t)(2 * l + 1) * M};
            pg8::gemm_phase<EpiResid, pg8::StaticOrder, GEMM_ALIGN_EPI, GEMM_SP2, RLX(3)>((PG8_LAS unsigned char*)lds, g, S, E, MYTID());
        } SEAM(p0 + 5);
        if (EN(7) && IN(p0 + 6)) REPS(7) {
            PH_PTRS
            STAGGER();
            pg8::Gemm g{(const pg8::bf16_t*)xb, (const pg8::bf16_t*)(wb + W_FF1), M, DFF, DM}; pg8::StaticOrder S; S.init(M, DFF, gx_, bx_);
#ifdef PROBE_KLOOP
            { EpiNull EN_{(float*)(ws + WS_CTL) + 2048}; pg8::gemm_phase<EpiNull, pg8::StaticOrder, GEMM_ALIGN_EPI, GEMM_SP2, GEMM_RELAX>((PG8_LAS unsigned char*)lds, g, S, EN_, MYTID()); }
#endif
            EpiFF1 E{(bf16*)(ws + WS_HID), rssb + (size_t)(2 * l + 1) * M};
            pg8::gemm_phase<EpiFF1, pg8::StaticOrder, GEMM_ALIGN_EPI, GEMM_SP2, RLX(4)>((PG8_LAS unsigned char*)lds, g, S, E, MYTID());
        } SEAM(p0 + 6);
        if (EN(8) && IN(p0 + 7)) {
            PH_PTRS
            pg8::Gemm g{(const pg8::bf16_t*)(ws + WS_HID), (const pg8::bf16_t*)(wb + W_FF2), M, DM, DFF, 1}; pg8::StaticOrder S; S.init(M, DM, gx_, bx_);
            EpiResid E{xb, rssb + (size_t)(2 * l + 2) * M};
            pg8::gemm_phase<EpiResid, pg8::StaticOrder, GEMM_ALIGN_EPI, GEMM_SP2, RLX(3)>((PG8_LAS unsigned char*)lds, g, S, E, MYTID());
        } SEAM(p0 + 7);
    }
    if (EN(9) && IN(N_PHASES - 1)) { MKFRAME phase_final(F); }
#undef IN
#undef SEAM
}

extern "C" void kernel_launch(void* const* d_in, const int* in_sizes, int n_in, void* d_out, int out_size, void* d_ws, size_t ws_size, hipStream_t stream) {
    static int grid = 0;
    if (grid == 0) {
        if (n_in != 30 || in_sizes[0] != M * DM || out_size != M * DM || ws_size < WS_END) { fprintf(stderr, "kernel_launch: unexpected problem (n_in %d, in0 %d, out %d, ws %zu)\n", n_in, n_in > 0 ? in_sizes[0] : -1, out_size, ws_size); grid = -1; return; }
        int dev = 0, cus = 0, per_cu = 0;
        if (hipGetDevice(&dev) != hipSuccess || hipDeviceGetAttribute(&cus, hipDeviceAttributeMultiprocessorCount, dev) != hipSuccess) { grid = -1; return; }
        if (hipFuncSetAttribute((const void*)hybrid_fwd, hipFuncAttributeMaxDynamicSharedMemorySize, LDS_BYTES) != hipSuccess) { fprintf(stderr, "kernel_launch: hipFuncSetAttribute failed\n"); grid = -1; return; }
        if (hipOccupancyMaxActiveBlocksPerMultiprocessor(&per_cu, (const void*)hybrid_fwd, NWAVES * 64, LDS_BYTES) != hipSuccess || per_cu < 1) fprintf(stderr, "kernel_launch: occupancy query reports %d\n", per_cu);
        (void)hipGetLastError();
        grid = cus;
    }
    if (grid < 0) return;
    if (hipMemsetAsync((char*)d_ws + WS_CTL, 0, CTL_ZERO_BYTES, stream) != hipSuccess) return;
    Args a{};
    for (int i = 0; i < 30; ++i) a.in[i] = (const float*)d_in[i];
    a.out = (float*)d_out; a.ws = (unsigned char*)d_ws;
#if MK_ONE_LAUNCH
    a.ph_lo = 0; a.ph_hi = N_PHASES;
    hipLaunchKernelGGL(hybrid_fwd, dim3(grid), dim3(NWAVES * 64), LDS_BYTES, stream, a);
#else
    for (int p = 0; p < N_PHASES; ++p) { a.ph_lo = p; a.ph_hi = p + 1; hipLaunchKernelGGL(hybrid_fwd, dim3(grid), dim3(NWAVES * 64), LDS_BYTES, stream, a); }
#endif
}
```

```cpp
#include <hip/hip_runtime.h>
#include <cstdio>
#include <cstdint>
#ifndef STAGGER_TICKS
#define STAGGER_TICKS 0
#endif

namespace pg8 {
#define PG8_LAS __attribute__((address_space(3)))
typedef unsigned short bf16_t;
typedef short bf16x8 __attribute__((ext_vector_type(8)));
typedef float f32x4 __attribute__((ext_vector_type(4)));
typedef unsigned u32x4 __attribute__((ext_vector_type(4)));
constexpr int BM = 256, BK = 64, HALF = 128, HTB = HALF * BK * 2  , STAGE_BYTES = 8 * HTB, NXCD = 8, WGM = 4;

__host__ __device__ __forceinline__ int lds_byte(int r, int c) { const int st = (r >> 4) * 2 + (c >> 5), rr = r & 15, cc = c & 31, ob = rr * 64 + cc * 2; return st * 1024 + (ob ^ (((ob >> 9) & 1) << 5)); }
__host__ __device__ __forceinline__ void stage_rc(int b, int& R, int& C) { const int st = b / 1024, sb = b % 1024, swz = sb ^ (((sb >> 9) & 1) << 5); R = (st >> 1) * 16 + swz / 64; C = (st & 1) * 32 + (swz % 64) / 2; }
__host__ __device__ __forceinline__ int perm32(int rho) { const int n = rho >> 4, i = rho & 15; return 8 * (i >> 2) + 4 * n + (i & 3); }

struct Unit { int pm, pn; };
struct Gemm { const bf16_t* A; const bf16_t* Bt; int M, N, K; int atile = 0; };

struct StaticOrder {
    int nM, nN, nwg, G, c;
    __host__ __device__ void init(int M, int N, int G_, int c_) { nM = M / BM; nN = N / BM; nwg = nM * nN; G = G_; c = c_; }
    __host__ __device__ bool next(int i, Unit& u) const {
        const long L = (long)i * G + c; if (L >= nwg) return false;
        int wgid = (int)L; { const int q = nwg / NXCD, r = nwg % NXCD, xcd = wgid % NXCD, off = wgid / NXCD; wgid = (xcd < r ? xcd * (q + 1) : r * (q + 1) + (xcd - r) * q) + off; }
        const int nig = WGM * nN, gid = wgid / nig, fm = gid * WGM, gsz = (nM - fm) < WGM ? (nM - fm) : WGM;
        u.pm = fm + ((wgid % nig) % gsz); u.pn = (wgid % nig) / gsz; return true;
    }
    __device__ __forceinline__ void a_ready(const Unit&) const {}
    __device__ __forceinline__ void done(const Unit&) const {}
};
__device__ __forceinline__ unsigned cvt_pk_bf16(float lo, float hi) { unsigned r; asm volatile("v_cvt_pk_bf16_f32 %0, %1, %2" : "=v"(r) : "v"(lo), "v"(hi)); return r; }
template <class Epi, class Sched, bool ALIGN_EPI = false, bool SP2 = false, bool RELAX = false>
__device__ __forceinline__ void gemm_phase(PG8_LAS unsigned char* lds, const Gemm g, const Sched& S, const Epi& E, int tid_in) {
    int tid_ = tid_in; asm volatile("" : "+v"(tid_));
    const int tid = tid_, wid = __builtin_amdgcn_readfirstlane(tid >> 6), lane = tid & 63, wr = wid >> 2, wc = wid & 3, fr = lane & 15, fq = lane >> 4;
    const int K = g.K, nt = K / BK;
    unsigned voffA[2], voffB[2];
#pragma unroll
    for (int i = 0; i < 2; ++i) { int R, C; stage_rc(tid * 16 + i * 8192, R, C); const int Rb = Epi::PERM ? ((R & ~31) + perm32(R & 31)) : R;
        voffA[i] = g.atile ? (unsigned)(R * BK + C) * 2u : (unsigned)(R * K + C) * 2u; voffB[i] = (unsigned)(Rb * K + C) * 2u; }
    const size_t kstep = (size_t)(BK * 2);
    const size_t hstep = (size_t)HALF * K * 2;
    const size_t kstepA = g.atile ? (size_t)(BM * BK * 2) : kstep, hstepA = g.atile ? (size_t)(HALF * BK * 2) : hstep;
    const size_t tstep = 2 * hstep;
    const unsigned ldsw = (unsigned)wid * 1024u;
    const int aoff = lds_byte(wr * 64 + fr, fq * 8), boff = lds_byte(wc * 32 + fr, fq * 8);
#define PG8_SA(b, h) (((b) * 2 + (h)) * HTB)
#define PG8_SB(b, h) ((4 + (b) * 2 + (h)) * HTB)
#define PG8_STAGE(bufoff, gbase, voff) do { _Pragma("unroll") for (int _i = 0; _i < 2; ++_i) \
        __builtin_amdgcn_global_load_lds((const unsigned*)((const char*)(gbase) + (voff)[_i]), (PG8_LAS unsigned*)(lds + (bufoff) + ldsw + _i * 8192), 16, 0, 0); } while (0)
#define PG8_LDA(dst, b, h) do { _Pragma("unroll") for (int m = 0; m < 4; ++m) _Pragma("unroll") for (int k = 0; k < 2; ++k) dst[m][k] = *(const PG8_LAS bf16x8*)(lds + PG8_SA(b, h) + aoff + m * 2048 + k * 1024); } while (0)
#define PG8_LDB(dst, b, h) do { _Pragma("unroll") for (int n = 0; n < 2; ++n) _Pragma("unroll") for (int k = 0; k < 2; ++k) dst[n][k] = *(const PG8_LAS bf16x8*)(lds + PG8_SB(b, h) + boff + n * 2048 + k * 1024); } while (0)
#define PG8_MMA(ai, bj, At, Bt) do { __builtin_amdgcn_s_setprio(1); _Pragma("unroll") for (int m = 0; m < 4; ++m) _Pragma("unroll") for (int n = 0; n < 2; ++n) _Pragma("unroll") for (int k = 0; k < 2; ++k) \
        acc[ai][bj][m][n] = __builtin_amdgcn_mfma_f32_16x16x32_bf16(Bt[n][k], At[m][k], acc[ai][bj][m][n], 0, 0, 0); __builtin_amdgcn_s_setprio(0); } while (0)
#define PG8_WAIT_V(n) asm volatile("s_waitcnt vmcnt(" #n ")" ::: "memory")
#define PG8_WAIT_L(n) asm volatile("s_waitcnt lgkmcnt(" #n ")" ::: "memory")
#define PG8_WAIT_VR() asm volatile("s_waitcnt vmcnt(%0)" :: "n"(8 + Epi::NST) : "memory")
#define PG8_BAR __builtin_amdgcn_s_barrier()
#define PG8_SCHED __builtin_amdgcn_sched_barrier(0)
    Unit cur, nxt; int ui = 0;
    if (!S.next(0, cur)) return;
    f32x4 acc[2][2][4][2];
#pragma unroll
    for (int a = 0; a < 2; ++a)
#pragma unroll
        for (int b = 0; b < 2; ++b)
#pragma unroll
            for (int m = 0; m < 4; ++m)
#pragma unroll
                for (int n = 0; n < 2; ++n) { acc[a][b][m][n] = (f32x4){0.f, 0.f, 0.f, 0.f}; if constexpr (RELAX) asm volatile("" : "+v"(acc[a][b][m][n])); }
    bf16x8 At[4][2], B0[2][2], B1[2][2];
    const char* cA = (const char*)g.A + (size_t)cur.pm * tstep; const char* cB = (const char*)g.Bt + (size_t)cur.pn * tstep;
    S.a_ready(cur);
    if constexpr (RELAX) {
        PG8_STAGE(PG8_SB(0, 0), cB, voffB); PG8_STAGE(PG8_SB(0, 1), cB + hstep, voffB); PG8_STAGE(PG8_SA(0, 0), cA, voffA); PG8_STAGE(PG8_SA(0, 1), cA + hstepA, voffA);
        PG8_STAGE(PG8_SB(1, 0), cB + kstep, voffB); PG8_STAGE(PG8_SA(1, 0), cA + kstepA, voffA); PG8_STAGE(PG8_SB(1, 1), cB + hstep + kstep, voffB); PG8_STAGE(PG8_SA(1, 1), cA + hstepA + kstepA, voffA);
        PG8_WAIT_V(0); PG8_BAR;
        if (wr == 1) PG8_BAR;
    } else if constexpr (SP2) {
        PG8_STAGE(PG8_SB(0, 0), cB, voffB); PG8_STAGE(PG8_SB(0, 1), cB + hstep, voffB); PG8_STAGE(PG8_SA(0, 0), cA, voffA); PG8_STAGE(PG8_SA(0, 1), cA + hstepA, voffA);
        if (wr == 1) PG8_BAR;
        PG8_WAIT_V(2); PG8_BAR;
        PG8_STAGE(PG8_SB(1, 0), cB + kstep, voffB); PG8_STAGE(PG8_SA(1, 0), cA + kstepA, voffA); PG8_STAGE(PG8_SB(1, 1), cB + hstep + kstep, voffB);
        PG8_WAIT_V(6); PG8_BAR;
    } else {
        PG8_STAGE(PG8_SB(0, 0), cB, voffB); PG8_STAGE(PG8_SA(0, 0), cA, voffA); PG8_STAGE(PG8_SB(0, 1), cB + hstep, voffB); PG8_STAGE(PG8_SA(0, 1), cA + hstepA, voffA);
        if (wr == 1) PG8_BAR;
        PG8_WAIT_V(4); PG8_BAR;
        PG8_STAGE(PG8_SB(1, 0), cB + kstep, voffB); PG8_STAGE(PG8_SA(1, 0), cA + kstepA, voffA); PG8_STAGE(PG8_SB(1, 1), cB + hstep + kstep, voffB);
        PG8_WAIT_V(6); PG8_BAR;
    }
#define PG8_TRIP_SP2(REL) do { \
        PG8_LDB(B0, 0, 0); PG8_LDB(B1, 0, 1); PG8_SCHED; PG8_LDA(At, 0, 0); if (!(REL)) PG8_STAGE(PG8_SA(1, 1), a1 + hstepA, voffA); \
        if (REL) PG8_WAIT_VR(); else PG8_WAIT_V(8); PG8_WAIT_L(0); PG8_BAR; PG8_MMA(0, 0, At, B0); PG8_MMA(0, 1, At, B1); PG8_BAR; PG8_SCHED; \
        PG8_LDA(At, 0, 1); PG8_STAGE(PG8_SB(0, 0), b2, voffB); PG8_STAGE(PG8_SB(0, 1), b2 + hstep, voffB); PG8_STAGE(PG8_SA(0, 0), a2, voffA); \
        if (REL) PG8_WAIT_VR(); else PG8_WAIT_V(8); PG8_WAIT_L(0); PG8_BAR; PG8_MMA(1, 0, At, B0); PG8_MMA(1, 1, At, B1); PG8_BAR; PG8_SCHED; \
        PG8_LDB(B0, 1, 0); PG8_LDB(B1, 1, 1); PG8_SCHED; PG8_LDA(At, 1, 0); PG8_STAGE(PG8_SA(0, 1), a2 + hstepA, voffA); \
        if (REL) PG8_WAIT_VR(); else PG8_WAIT_V(8); PG8_WAIT_L(0); PG8_BAR; PG8_MMA(0, 0, At, B0); PG8_MMA(0, 1, At, B1); PG8_BAR; PG8_SCHED; \
        PG8_LDA(At, 1, 1); PG8_STAGE(PG8_SB(1, 0), b3, voffB); PG8_STAGE(PG8_SB(1, 1), b3 + hstep, voffB); PG8_STAGE(PG8_SA(1, 0), a3, voffA); \
        PG8_WAIT_V(8); PG8_WAIT_L(0); PG8_BAR; PG8_MMA(1, 0, At, B0); PG8_MMA(1, 1, At, B1); PG8_BAR; PG8_SCHED; } while (0)
    if constexpr (RELAX) {
        static_assert(SP2 && ALIGN_EPI && !Epi::AFTER_DRAIN, "RELAX variant");
        for (;;) {
            const bool has_next = S.next(ui + 1, nxt);
            const char* nA = has_next ? (const char*)g.A + (size_t)nxt.pm * tstep : cA; const char* nB = has_next ? (const char*)g.Bt + (size_t)nxt.pn * tstep : cB;
            int t1 = 2; asm volatile("" : "+s"(t1));
            for (int t = 0; t < t1; t += 2) { const char* a1 = cA; (void)a1; const char* a2 = cA + (size_t)(t + 2) * kstepA; const char* b2 = cB + (size_t)(t + 2) * kstep; const char* a3 = a2 + kstepA; const char* b3 = b2 + kstep; PG8_TRIP_SP2(1); }
            for (int t = 2; t < nt; t += 2) {
                const bool last = (t == nt - 2);
                const char* a1 = cA + (size_t)(t + 1) * kstepA;
                const char* a2 = last ? nA : cA + (size_t)(t + 2) * kstepA; const char* b2 = last ? nB : cB + (size_t)(t + 2) * kstep;
                const char* a3 = a2 + kstepA; const char* b3 = b2 + kstep;
                PG8_TRIP_SP2(0);
            }
            if (has_next) PG8_STAGE(PG8_SA(1, 1), nA + kstepA + hstepA, voffA);
            if (wr == 0) PG8_BAR;
            E(acc, cur, wr, wc, fr, fq); S.done(cur);
            if (!has_next) break;
#pragma unroll
            for (int a = 0; a < 2; ++a)
#pragma unroll
                for (int b = 0; b < 2; ++b)
#pragma unroll
                    for (int m = 0; m < 4; ++m)
#pragma unroll
                        for (int n = 0; n < 2; ++n) { acc[a][b][m][n] = (f32x4){0.f, 0.f, 0.f, 0.f}; asm volatile("" : "+v"(acc[a][b][m][n])); }
            cur = nxt; cA = nA; cB = nB; ++ui;
            if (wr == 1) PG8_BAR;
        }
    } else {
    for (;;) {
        const bool has_next = S.next(ui + 1, nxt);
        const char* nA = has_next ? (const char*)g.A + (size_t)nxt.pm * tstep : cA; const char* nB = has_next ? (const char*)g.Bt + (size_t)nxt.pn * tstep : cB;
        for (int t = 0; t < nt; t += 2) {
            const bool last = (t == nt - 2);
            const char* a1 = cA + (size_t)(t + 1) * kstepA;
            const char* a2 = last ? nA : cA + (size_t)(t + 2) * kstepA; const char* b2 = last ? nB : cB + (size_t)(t + 2) * kstep;
            const char* a3 = a2 + kstepA; const char* b3 = b2 + kstep;
            if (last && has_next) S.a_ready(nxt);
            if constexpr (SP2) {
            PG8_LDB(B0, 0, 0); PG8_LDB(B1, 0, 1); PG8_SCHED; PG8_LDA(At, 0, 0); PG8_STAGE(PG8_SA(1, 1), a1 + hstepA, voffA);
            PG8_WAIT_V(8); PG8_WAIT_L(0); PG8_BAR; PG8_MMA(0, 0, At, B0); PG8_MMA(0, 1, At, B1); PG8_BAR; PG8_SCHED;
            PG8_LDA(At, 0, 1); PG8_STAGE(PG8_SB(0, 0), b2, voffB); PG8_STAGE(PG8_SB(0, 1), b2 + hstep, voffB); PG8_STAGE(PG8_SA(0, 0), a2, voffA);
            PG8_WAIT_V(8); PG8_WAIT_L(0); PG8_BAR; PG8_MMA(1, 0, At, B0); PG8_MMA(1, 1, At, B1); PG8_BAR; PG8_SCHED;
            PG8_LDB(B0, 1, 0); PG8_LDB(B1, 1, 1); PG8_SCHED; PG8_LDA(At, 1, 0); PG8_STAGE(PG8_SA(0, 1), a2 + hstepA, voffA);
            PG8_WAIT_V(8); PG8_WAIT_L(0); PG8_BAR; PG8_MMA(0, 0, At, B0); PG8_MMA(0, 1, At, B1); PG8_BAR; PG8_SCHED;
            PG8_LDA(At, 1, 1); PG8_STAGE(PG8_SB(1, 0), b3, voffB); PG8_STAGE(PG8_SB(1, 1), b3 + hstep, voffB); PG8_STAGE(PG8_SA(1, 0), a3, voffA);
            PG8_WAIT_V(8); PG8_WAIT_L(0); PG8_BAR; PG8_MMA(1, 0, At, B0); PG8_MMA(1, 1, At, B1); PG8_BAR; PG8_SCHED;
            } else {
            PG8_LDB(B0, 0, 0); PG8_SCHED; PG8_LDA(At, 0, 0); PG8_STAGE(PG8_SA(1, 1), a1 + hstepA, voffA);
            PG8_WAIT_L(8); PG8_BAR; PG8_WAIT_L(0); PG8_MMA(0, 0, At, B0); PG8_BAR; PG8_SCHED;
            PG8_LDB(B1, 0, 1); PG8_STAGE(PG8_SB(0, 0), b2, voffB);
            PG8_BAR; PG8_WAIT_L(0); PG8_MMA(0, 1, At, B1); PG8_BAR;
            PG8_LDA(At, 0, 1); PG8_STAGE(PG8_SA(0, 0), a2, voffA);
            PG8_BAR; PG8_WAIT_L(0); PG8_MMA(1, 0, At, B0); PG8_BAR; PG8_SCHED;
            PG8_STAGE(PG8_SB(0, 1), b2 + hstep, voffB);
            PG8_WAIT_V(6); PG8_BAR; PG8_MMA(1, 1, At, B1); PG8_BAR;
            PG8_LDB(B0, 1, 0); PG8_SCHED; PG8_LDA(At, 1, 0); PG8_STAGE(PG8_SA(0, 1), a2 + hstepA, voffA);
            PG8_WAIT_L(8); PG8_BAR; PG8_WAIT_L(0); PG8_MMA(0, 0, At, B0); PG8_BAR; PG8_SCHED;
            PG8_LDB(B1, 1, 1); PG8_STAGE(PG8_SB(1, 0), b3, voffB);
            PG8_BAR; PG8_WAIT_L(0); PG8_MMA(0, 1, At, B1); PG8_BAR;
            PG8_LDA(At, 1, 1); PG8_STAGE(PG8_SA(1, 0), a3, voffA);
            PG8_BAR; PG8_WAIT_L(0); PG8_MMA(1, 0, At, B0); PG8_BAR; PG8_SCHED;
            PG8_STAGE(PG8_SB(1, 1), b3 + hstep, voffB);
            PG8_WAIT_V(6); PG8_BAR; PG8_MMA(1, 1, At, B1); PG8_BAR;
            }
        }
        if constexpr (ALIGN_EPI) { if (wr == 0) PG8_BAR; }
        if constexpr (!Epi::AFTER_DRAIN) { E(acc, cur, wr, wc, fr, fq); S.done(cur); }
        if (!has_next) break;
#pragma unroll
        for (int a = 0; a < 2; ++a)
#pragma unroll
            for (int b = 0; b < 2; ++b)
#pragma unroll
                for (int m = 0; m < 4; ++m)
#pragma unroll
                    for (int n = 0; n < 2; ++n) acc[a][b][m][n] = (f32x4){0.f, 0.f, 0.f, 0.f};
        cur = nxt; cA = nA; cB = nB; ++ui;
        if constexpr (ALIGN_EPI) { if (wr == 1) PG8_BAR; }
    }
    }
    PG8_WAIT_V(0);
    if constexpr (!ALIGN_EPI) { if (wr == 0) PG8_BAR; }
    PG8_BAR;
    if constexpr (Epi::AFTER_DRAIN) { E.fused(acc, cur, wr, wc, fr, fq, lds, wid, lane); S.done(cur); }
#undef PG8_SA
#undef PG8_SB
#undef PG8_STAGE
#undef PG8_LDA
#undef PG8_LDB
#undef PG8_MMA
#undef PG8_WAIT_V
#undef PG8_WAIT_L
#undef PG8_BAR
#undef PG8_SCHED
#undef PG8_TRIP_SP2
#undef PG8_WAIT_VR
}
}

constexpr int NBATCH = 8, SEQ = 4096, DM = 1024, DEPTH = 2, DFF = 4096;
constexpr int M = NBATCH * SEQ;
constexpr int IN_COLS = 3284;
constexpr int NIN = 3584;
constexpr int A16_LD = 3328, A32_LD = 256;
constexpr float EPS = 1e-6f;
constexpr float P_SCALE = 8.0f;
constexpr int TOPK = 256;
constexpr int C_QL = 0, C_IQ = 512, C_BQ = 768, C_BK = 1024, C_BV = 1280, C_BR = 1536, C_CY = 1792, C_DQ = 2048, C_DI = 2304, C_DG = 2560;
constexpr int C_CKV = 0, C_IK = 128, C_IW = 192, C_LR = 196;
constexpr int C_CX = 2816, C_DF = 3072;

constexpr size_t MiB = 1u << 20;
constexpr size_t WS_CTL = 0, CTL_ZERO_BYTES = 65536;
constexpr size_t WS_TAB = 1 * MiB;
constexpr size_t WS_RSS = 2 * MiB;
constexpr size_t WS_CKSS = 3 * MiB + 512 * 1024;
constexpr size_t WS_W = 4 * MiB;
constexpr size_t W_IN = 0, W_GATE = 7340032, W_BRA = 15728640, W_BRB = 16777216, W_BRC = 17301504, W_BRD = 17825792, W_OUT = 18350080, W_FF1 = 20447232, W_FF2 = 28835840, W_LAYER = 37224448;
constexpr size_t WS_XB = 76 * MiB;
constexpr size_t WS_A16 = 140 * MiB;
constexpr size_t WS_A32 = 348 * MiB;
constexpr size_t WS_P = 140 * MiB;
constexpr size_t WS_HID = 140 * MiB;
constexpr size_t WS_OLAT = 412 * MiB, WS_YB = 444 * MiB, WS_YC = 460 * MiB, WS_YD = 476 * MiB;
constexpr size_t WS_MRG = 412 * MiB;
constexpr size_t WS_CKV = 492 * MiB;
constexpr size_t WS_IK = 500 * MiB;
constexpr size_t WS_CKVT = 504 * MiB;
constexpr size_t WS_END = 512 * MiB;
static_assert(WS_W + 2 * W_LAYER <= WS_XB && WS_A16 + (size_t)M * A16_LD * 2 <= WS_A32 && WS_A32 + (size_t)M * A32_LD * 4 <= WS_OLAT && WS_P + (size_t)M * 4096 * 2 <= WS_OLAT, "ws map");
constexpr int CW_TMO = 0;
constexpr int CW_BAR = 4096;

constexpr int RING_BYTES = 131072;
constexpr int LDSCTL_OFF = RING_BYTES, MISC_OFF = LDSCTL_OFF + 320;
constexpr int LDS_BYTES = 147456;
constexpr int NWAVES = 8;

#define GAS __attribute__((address_space(1)))
#define LAS __attribute__((address_space(3)))
typedef unsigned short bf16;
typedef float f32x4 __attribute__((ext_vector_type(4)));
typedef float f32x2 __attribute__((ext_vector_type(2)));
typedef unsigned u32x4 __attribute__((ext_vector_type(4)));
typedef unsigned u32x2 __attribute__((ext_vector_type(2)));

typedef __bf16 bf16x2_t __attribute__((ext_vector_type(2)));
__device__ __forceinline__ unsigned pk2(float lo, float hi) { bf16x2_t v; v[0] = (__bf16)lo; v[1] = (__bf16)hi; return __builtin_bit_cast(unsigned, v); }
__device__ __forceinline__ unsigned f2bf(float f) { return (unsigned)__builtin_bit_cast(unsigned short, (__bf16)f); }
__device__ __forceinline__ float bf2f(unsigned b) { return __uint_as_float(b << 16); }
__device__ __forceinline__ float bflo(unsigned w) { return __uint_as_float(w << 16); }
__device__ __forceinline__ float bfhi(unsigned w) { return __uint_as_float(w & 0xffff0000u); }
__device__ __forceinline__ float fsigmoid(float x) { return __builtin_amdgcn_rcpf(1.0f + __builtin_amdgcn_exp2f(-1.44269504f * x)); }
__device__ __forceinline__ float fsilu(float x) { return x * fsigmoid(x); }
__device__ __forceinline__ float fgelu_tanh(float x) { return x * fsigmoid(1.59576912f * (x + 0.044715f * x * x * x)); }
__device__ __forceinline__ float flogsigmoid(float x) { return -fmaxf(-x, 0.f) - 0.69314718f * __builtin_amdgcn_logf(1.0f + __builtin_amdgcn_exp2f(-1.44269504f * fabsf(x))); }
typedef unsigned long long rss_t;
__device__ __forceinline__ rss_t rss_enc(float ss) { return (rss_t)(ss * 1048576.0f + 0.5f); }
__device__ __forceinline__ float rss_dec(rss_t q) { return (float)q * (1.0f / 1048576.0f); }
__device__ __forceinline__ float wave_sum(float v) {
#pragma unroll
    for (int o = 1; o < 64; o <<= 1) v += __shfl_xor(v, o);
    return v;
}
__device__ __forceinline__ float wave_max(float v) {
#pragma unroll
    for (int o = 1; o < 64; o <<= 1) v = fmaxf(v, __shfl_xor(v, o));
    return v;
}
__device__ __forceinline__ int wave_isum(int v) {
#pragma unroll
    for (int o = 1; o < 64; o <<= 1) v += __shfl_xor(v, o);
    return v;
}

#define XB_TMO      128
#define XB_XCNT(j)  (256  + 64 * (j))
#define XB_XSUB(j)  (1280 + 64 * (j))
#define XB_XGEN(j)  (2304 + 64 * (j))
#define XB_TOP      3328
#define XB_TOPGEN   3392
#define XCD_BAR_WORDS 3456
#define XB_SPIN_CAP (1u << 18)
__device__ __forceinline__ unsigned xb_ld(unsigned* p)              { return __hip_atomic_load(p, __ATOMIC_RELAXED, __HIP_MEMORY_SCOPE_AGENT); }
__device__ __forceinline__ unsigned xb_add(unsigned* p, unsigned v) { return __hip_atomic_fetch_add(p, v, __ATOMIC_RELAXED, __HIP_MEMORY_SCOPE_AGENT); }
__device__ __forceinline__ unsigned xb_xcc_id() { return (unsigned)__builtin_amdgcn_s_getreg((3 << 11) | 20) & 0xFu; }
#define XB_SPIN(cond, bar) do { unsigned _sp = 0; while (cond) { __builtin_amdgcn_s_sleep(1); \
    if ((++_sp & 255u) == 0u) { if (xb_ld(&(bar)[XB_TMO])) break; if (_sp > XB_SPIN_CAP) { atomicAdd(&(bar)[XB_TMO], 1u); break; } } } } while (0)
struct XcdBarrier { unsigned* bar; unsigned x; volatile LAS unsigned* st; };
__device__ __forceinline__ XcdBarrier xcd_barrier_post(unsigned* bar, volatile LAS unsigned* st) {
    XcdBarrier b; b.bar = bar; b.x = xb_xcc_id(); b.st = st;
    if (threadIdx.x == 0) (void)xb_add(&bar[XB_XCNT(b.x)], 1u);
    return b;
}
__device__ __forceinline__ void xcd_barrier_complete(unsigned* bar, unsigned x, unsigned& nloc, unsigned& nx) {
    const unsigned G = gridDim.x * gridDim.y * gridDim.z;
    unsigned sum, cnt, mine, sp = 0u;
    for (;;) {
        sum = 0u; cnt = 0u; mine = 0u;
#pragma unroll
        for (unsigned j = 0; j < 16; ++j) { const unsigned c = xb_ld(&bar[XB_XCNT(j)]); sum += c; cnt += (c > 0u) ? 1u : 0u; mine = (j == x) ? c : mine; }
        if (sum == G) break;
        __builtin_amdgcn_s_sleep(1);
        if ((++sp & 255u) == 0u) { if (xb_ld(&bar[XB_TMO])) break; if (sp > XB_SPIN_CAP) { atomicAdd(&bar[XB_TMO], 1u); break; } }
    }
    nloc = mine > 0u ? mine : 1u; nx = cnt > 0u ? cnt : 1u;
}
__device__ __forceinline__ void xcd_barrier(const XcdBarrier& b, bool is_t0) {
    asm volatile("s_waitcnt vmcnt(0)" ::: "memory");
    __syncthreads();
    if (is_t0) {
        unsigned* bar = b.bar;
        __builtin_amdgcn_s_waitcnt(0);
        unsigned nloc = b.st[0], nx = b.st[1];
        if (nloc == 0u) { xcd_barrier_complete(bar, b.x, nloc, nx); b.st[0] = nloc; b.st[1] = nx; }
        const unsigned old = xb_add(&bar[XB_XSUB(b.x)], 1u);
        const unsigned gen = old / nloc;
        if (old + 1u == (gen + 1u) * nloc) {
            __builtin_amdgcn_fence(__ATOMIC_RELEASE, "agent");
            asm volatile("s_waitcnt vmcnt(0)" ::: "memory");
            const unsigned og = xb_add(&bar[XB_TOP], 1u);
            const unsigned tg = og / nx;
            if (og + 1u == (tg + 1u) * nx) xb_add(&bar[XB_TOPGEN], 1u);
            else XB_SPIN(xb_ld(&bar[XB_TOPGEN]) == tg, bar);
            __builtin_amdgcn_fence(__ATOMIC_ACQUIRE, "agent");
            xb_add(&bar[XB_XGEN(b.x)], 1u);
            asm volatile("s_waitcnt vmcnt(0)" ::: "memory");
        } else {
            XB_SPIN(xb_ld(&bar[XB_XGEN(b.x)]) == gen, bar);
            __builtin_amdgcn_fence(__ATOMIC_ACQUIRE, "agent");
            asm volatile("s_waitcnt vmcnt(0)" ::: "memory");
        }
    }
    __syncthreads();
}

#ifndef USE_NT
#define USE_NT 0
#endif
#ifndef USE_SC1
#define USE_SC1 1
#endif
__device__ __forceinline__ void st_wt(u32x4* p, u32x4 v) { asm volatile("global_store_dwordx4 %0, %1, off sc1\n\ts_nop 1" :: "v"(p), "v"(v) : "memory"); }
__device__ __forceinline__ void st_wt(f32x4* p, f32x4 v) { asm volatile("global_store_dwordx4 %0, %1, off sc1\n\ts_nop 1" :: "v"(p), "v"(v) : "memory"); }
__device__ __forceinline__ void st_wt(u32x2* p, u32x2 v) { asm volatile("global_store_dwordx2 %0, %1, off sc1\n\ts_nop 1" :: "v"(p), "v"(v) : "memory"); }
#ifndef SC1_MASK
#define SC1_MASK 0x10u
#endif
#define ST_POL(bit, p, v) do { if ((SC1_MASK >> (bit)) & 1u) st_wt((p), (v)); else *(p) = (v); } while (0)
struct EpiInProj {
    static constexpr bool PERM = true, AFTER_DRAIN = false, PROBE2 = true;
    static constexpr int NST = 16;
    bf16* a16; float* a32; const rss_t* rss; const LAS float* lbA; const LAS float* lbB;
    bf16* ckv; bf16* ik; rss_t* ckss;
    __device__ __forceinline__ void operator()(const pg8::f32x4 (&acc)[2][2][4][2], const pg8::Unit& u, int wr, int wc, int fr, int fq) const {
        const int pn = u.pn, row0 = u.pm * 256 + wr * 64 + fr, cl = wc * 32 + 8 * fq;
        float ssv[8]; rss_t ssr[8];
#pragma unroll
        for (int g = 0; g < 8; ++g) ssr[g] = rss[row0 + (g >> 2) * 128 + (g & 3) * 16];
        asm volatile("" : "+v"(ssr[0]), "+v"(ssr[1]), "+v"(ssr[2]), "+v"(ssr[3]), "+v"(ssr[4]), "+v"(ssr[5]), "+v"(ssr[6]), "+v"(ssr[7]) :: "memory");
#pragma unroll
        for (int g = 0; g < 8; ++g) ssv[g] = rss_dec(ssr[g]);
        if (pn != 11) {
            const int act = (pn == 6 || pn == 8 || pn == 10) ? 1 : (pn == 7 ? 2 : (pn == 13 ? 3 : 0)), pc = pn < 11 ? pn : pn - 1;
#pragma unroll
            for (int ai = 0; ai < 2; ++ai)
#pragma unroll
                for (int m = 0; m < 4; ++m) { bf16* rowp = a16 + (size_t)(row0 + ai * 128 + m * 16) * A16_LD + pc * 256 + cl; const float sc = __builtin_amdgcn_rsqf(ssv[ai * 4 + m] * (1.0f / DM) + EPS);
#pragma unroll
                    for (int bj = 0; bj < 2; ++bj) { float v[8];
#pragma unroll
                        for (int j = 0; j < 4; ++j) { v[j] = acc[ai][bj][m][0][j] * sc; v[4 + j] = acc[ai][bj][m][1][j] * sc; }
                        if (act == 1) {
#pragma unroll
                            for (int j = 0; j < 8; ++j) v[j] = fsilu(v[j]); }
                        else if (act == 2) {
#pragma unroll
                            for (int j = 0; j < 8; ++j) v[j] = fgelu_tanh(v[j]); }
                        else if (act == 3) {
#pragma unroll
                            for (int n = 0; n < 2; ++n) { const f32x4 la = *(const LAS f32x4*)(lbA + cl + bj * 128 + 4 * n), lb = *(const LAS f32x4*)(lbB + cl + bj * 128 + 4 * n);
#pragma unroll
                                for (int j = 0; j < 4; ++j) { const float b = lb[j] + flogsigmoid(v[4 * n + j]), a = la[j]; const float mx = fmaxf(a, b), d = -fabsf(a - b);
                                    v[4 * n + j] = mx + 0.69314718f * __builtin_amdgcn_logf(1.0f + __builtin_amdgcn_exp2f(1.44269504f * d)); } } }
                        u32x4 w; w.x = pk2(v[0], v[1]); w.y = pk2(v[2], v[3]); w.z = pk2(v[4], v[5]); w.w = pk2(v[6], v[7]);
                        ST_POL(0, (u32x4*)(rowp + bj * 128), w); }
                    asm volatile("" ::: "memory"); }
        } else {
#pragma unroll
            for (int ai = 0; ai < 2; ++ai)
#pragma unroll
                for (int m = 0; m < 4; ++m) { float* rowp = a32 + (size_t)(row0 + ai * 128 + m * 16) * A32_LD + cl; const float sc = __builtin_amdgcn_rsqf(ssv[ai * 4 + m] * (1.0f / DM) + EPS);
                    if (wc >= 2) {
#pragma unroll
                        for (int n = 0; n < 2; ++n) { const f32x4 v = acc[ai][1][m][n] * sc; ST_POL(0, (f32x4*)(rowp + 128 + 4 * n), v); } }
                    { const int r_ = row0 + ai * 128 + m * 16;
                        const f32x4 c0 = acc[ai][0][m][0] * sc, c1 = acc[ai][0][m][1] * sc;
                        u32x4 w; w.x = pk2(c0[0], c0[1]); w.y = pk2(c0[2], c0[3]); w.z = pk2(c1[0], c1[1]); w.w = pk2(c1[2], c1[3]);
                        *(u32x4*)(ckv + (size_t)r_ * 128 + cl) = w;
                        float ss = (c0[0] * c0[0] + c0[1] * c0[1]) + (c0[2] * c0[2] + c0[3] * c0[3]) + (c1[0] * c1[0] + c1[1] * c1[1]) + (c1[2] * c1[2] + c1[3] * c1[3]);
                        ss += __shfl_xor(ss, 16); ss += __shfl_xor(ss, 32);
                        if (fq == 0) __hip_atomic_fetch_add(ckss + r_, rss_enc(ss), __ATOMIC_RELAXED, __HIP_MEMORY_SCOPE_AGENT);
                        if (wc < 2) { const f32x4 k0 = acc[ai][1][m][0] * sc, k1 = acc[ai][1][m][1] * sc;
                            u32x4 wk; wk.x = pk2(k0[0], k0[1]); wk.y = pk2(k0[2], k0[3]); wk.z = pk2(k1[0], k1[1]); wk.w = pk2(k1[2], k1[3]);
                            *(u32x4*)(ik + (size_t)r_ * 64 + cl) = wk; } }
                    asm volatile("" ::: "memory"); }
        }
    }
};
struct EpiBf16Plain {
    static constexpr bool PERM = true, AFTER_DRAIN = false, PROBE2 = true;
    static constexpr int NST = 16;
    bf16* O; int ldc; int cbase; int stacked;
    __device__ __forceinline__ void operator()(const pg8::f32x4 (&acc)[2][2][4][2], const pg8::Unit& u, int wr, int wc, int fr, int fq) const {
        const int pm_ = stacked ? (u.pm & 127) : u.pm, pn_ = stacked ? (u.pn + 4) : u.pn;
        const int row0 = pm_ * 256 + wr * 64 + fr, col0 = cbase + pn_ * 256 + wc * 32 + 8 * fq;
        unsigned char* O8 = (unsigned char*)O;
#pragma unroll
        for (int ai = 0; ai < 2; ++ai)
#pragma unroll
            for (int m = 0; m < 4; ++m) { const int r_ = row0 + ai * 128 + m * 16; unsigned char* rowp = O8 + (size_t)(r_ >> 8) * (256 * ldc) + (size_t)(col0 >> 6) * (256 * 64) + (size_t)(r_ & 255) * 64 + (col0 & 63);
#pragma unroll
                for (int bj = 0; bj < 2; ++bj) { float v[8];
#pragma unroll
                    for (int e = 0; e < 4; ++e) { v[e] = __builtin_amdgcn_fmed3f(acc[ai][bj][m][0][e] * P_SCALE, -448.f, 448.f); v[4 + e] = __builtin_amdgcn_fmed3f(acc[ai][bj][m][1][e] * P_SCALE, -448.f, 448.f); }
                    u32x2 w; int t0 = __builtin_amdgcn_cvt_pk_fp8_f32(v[0], v[1], 0, false); t0 = __builtin_amdgcn_cvt_pk_fp8_f32(v[2], v[3], t0, true);
                    int t1 = __builtin_amdgcn_cvt_pk_fp8_f32(v[4], v[5], 0, false); t1 = __builtin_amdgcn_cvt_pk_fp8_f32(v[6], v[7], t1, true);
                    w.x = (unsigned)t0; w.y = (unsigned)t1;
                    ST_POL(1, (u32x2*)(rowp + bj * 2 * (256 * 64)), w); } }
    }
};
struct StackOrder {
    pg8::StaticOrder so; int G, c, nbr;
    __device__ void init(int G_, int c_, int nbr_) { so.init(M, DM, G_, c_); G = G_; c = c_; nbr = nbr_; }
    __device__ bool next(int i, pg8::Unit& u) const { const int per = so.nwg / G;   const int bsel = i / per; if (bsel >= nbr) return false; pg8::Unit t; if (!so.next(i - bsel * per, t)) return false; u.pm = 128 * bsel + t.pm; u.pn = 4 * bsel + t.pn; return true; }
    __device__ __forceinline__ void a_ready(const pg8::Unit&) const {}
    __device__ __forceinline__ void done(const pg8::Unit&) const {}
};
struct EpiGateMerge {
    static constexpr bool PERM = false, AFTER_DRAIN = false, PROBE2 = true;
    static constexpr int NST = 32;
    const bf16* P; bf16* mrg; const rss_t* rss; const LAS bf16* bl;
    __device__ __forceinline__ void operator()(const pg8::f32x4 (&acc)[2][2][4][2], const pg8::Unit& u, int wr, int wc, int fr, int fq) const {
        const int row0 = u.pm * 256 + wr * 64 + fr, ch = u.pn * 64 + wc * 16 + fq * 4;
        const unsigned char* Pt = (const unsigned char*)P + (size_t)u.pm * (256 * 4096) + (size_t)u.pn * (256 * 64) + wc * 16 + fq * 4;
        bf16* Mt = mrg + (size_t)u.pm * (256 * DM) + (size_t)u.pn * (256 * 64) + wc * 16 + fq * 4;
        unsigned pw[2][4]; rss_t ssn[2];
#pragma unroll
        for (int b4 = 0; b4 < 4; ++b4) pw[0][b4] = *(const unsigned*)(Pt + (size_t)(row0 & 255) * 64 + (size_t)b4 * (16 * 256 * 64));
        ssn[0] = rss[row0];
        asm volatile("" ::: "memory");
#pragma unroll
        for (int g = 0; g < 8; ++g) { const int ai = g >> 2, m = g & 3, r = row0 + ai * 128 + m * 16;
            if (g + 1 < 8) { const int rn = row0 + ((g + 1) >> 2) * 128 + ((g + 1) & 3) * 16; ssn[(g + 1) & 1] = rss[rn];
#pragma unroll
                for (int b4 = 0; b4 < 4; ++b4) pw[(g + 1) & 1][b4] = *(const unsigned*)(Pt + (size_t)(rn & 255) * 64 + (size_t)b4 * (16 * 256 * 64)); }
            const float sc = __builtin_amdgcn_rsqf(rss_dec(ssn[g & 1]) * (1.0f / DM) + EPS); float o0 = 0.f, o1 = 0.f, o2 = 0.f, o3 = 0.f;
#pragma unroll
            for (int bj = 0; bj < 2; ++bj)
#pragma unroll
                for (int n = 0; n < 2; ++n) { const unsigned pq = pw[g & 1][2 * bj + n]; const f32x2 p01 = __builtin_amdgcn_cvt_pk_f32_fp8((int)pq, false), p23 = __builtin_amdgcn_cvt_pk_f32_fp8((int)pq, true); const u32x2 bw = *(const LAS u32x2*)(bl + (2 * bj + n) * 1024 + ch);
                    const f32x4 a = acc[ai][bj][m][n] * sc + (f32x4){bflo(bw.x), bfhi(bw.x), bflo(bw.y), bfhi(bw.y)};
                    o0 += fsigmoid(a[0]) * p01[0]; o1 += fsigmoid(a[1]) * p01[1]; o2 += fsigmoid(a[2]) * p23[0]; o3 += fsigmoid(a[3]) * p23[1]; }
            u32x2 w; w.x = pk2(o0 * (1.0f / P_SCALE), o1 * (1.0f / P_SCALE)); w.y = pk2(o2 * (1.0f / P_SCALE), o3 * (1.0f / P_SCALE));
            ST_POL(2, (u32x2*)(Mt + (size_t)(r & 255) * 64), w); asm volatile("" ::: "memory"); }
    }
};
struct EpiResid {
    static constexpr bool PERM = true, AFTER_DRAIN = false, PROBE2 = false;
    static constexpr int NST = 32;
    bf16* xb; rss_t* rss_out;
    __device__ __forceinline__ void operator()(const pg8::f32x4 (&acc)[2][2][4][2], const pg8::Unit& u, int wr, int wc, int fr, int fq) const {
        const int row0 = u.pm * 256 + wr * 64 + fr, col0 = u.pn * 256 + wc * 32 + 8 * fq;
        u32x4 xin[2][2];
#pragma unroll
        for (int bj = 0; bj < 2; ++bj) xin[0][bj] = *(const u32x4*)(xb + (size_t)row0 * DM + col0 + bj * 128);
        asm volatile("" ::: "memory");
#pragma unroll
        for (int g = 0; g < 8; ++g) { const int ai = g >> 2, m = g & 3, r = row0 + ai * 128 + m * 16; const size_t off = (size_t)r * DM + col0; float ss = 0.f;
            if (g + 1 < 8) { const size_t offn = (size_t)(row0 + ((g + 1) >> 2) * 128 + ((g + 1) & 3) * 16) * DM + col0;
#pragma unroll
                for (int bj = 0; bj < 2; ++bj) xin[(g + 1) & 1][bj] = *(const u32x4*)(xb + offn + bj * 128); }
#pragma unroll
            for (int bj = 0; bj < 2; ++bj) { const u32x4 xw = xin[g & 1][bj];
                const f32x4 v0 = (f32x4){bflo(xw.x), bfhi(xw.x), bflo(xw.y), bfhi(xw.y)} + acc[ai][bj][m][0], v1 = (f32x4){bflo(xw.z), bfhi(xw.z), bflo(xw.w), bfhi(xw.w)} + acc[ai][bj][m][1];
                ss += (v0[0] * v0[0] + v0[1] * v0[1]) + (v0[2] * v0[2] + v0[3] * v0[3]) + (v1[0] * v1[0] + v1[1] * v1[1]) + (v1[2] * v1[2] + v1[3] * v1[3]);
                u32x4 w; w.x = pk2(v0[0], v0[1]); w.y = pk2(v0[2], v0[3]); w.z = pk2(v1[0], v1[1]); w.w = pk2(v1[2], v1[3]); ST_POL(3, (u32x4*)(xb + off + bj * 128), w); }
            ss += __shfl_xor(ss, 16); ss += __shfl_xor(ss, 32);
            if (fq == 0) __hip_atomic_fetch_add(rss_out + r, rss_enc(ss), __ATOMIC_RELAXED, __HIP_MEMORY_SCOPE_AGENT); asm volatile("" ::: "memory"); }
    }
};
struct EpiNull {
    static constexpr bool PERM = true, AFTER_DRAIN = false, PROBE2 = false;
    static constexpr int NST = 0;
    float* sink;
    __device__ __forceinline__ void operator()(const pg8::f32x4 (&acc)[2][2][4][2], const pg8::Unit& u, int wr, int wc, int fr, int fq) const {
        float s = 0.f;
#pragma unroll
        for (int ai = 0; ai < 2; ++ai)
#pragma unroll
            for (int bj = 0; bj < 2; ++bj)
#pragma unroll
                for (int m = 0; m < 4; ++m)
#pragma unroll
                    for (int n = 0; n < 2; ++n) s += acc[ai][bj][m][n][0] + acc[ai][bj][m][n][1] + acc[ai][bj][m][n][2] + acc[ai][bj][m][n][3];
        if (s == 123456.789f) sink[0] = s;
    }
};
struct EpiFF1 {
    static constexpr bool PERM = true, AFTER_DRAIN = false, PROBE2 = true;
    static constexpr int NST = 16;
    bf16* O; const rss_t* rss;
    __device__ __forceinline__ void operator()(const pg8::f32x4 (&acc)[2][2][4][2], const pg8::Unit& u, int wr, int wc, int fr, int fq) const {
        const int row0 = u.pm * 256 + wr * 64 + fr, col0 = u.pn * 256 + wc * 32 + 8 * fq;
        float ssv[8]; rss_t ssr[8];
#pragma unroll
        for (int g = 0; g < 8; ++g) ssr[g] = rss[row0 + (g >> 2) * 128 + (g & 3) * 16];
        asm volatile("" : "+v"(ssr[0]), "+v"(ssr[1]), "+v"(ssr[2]), "+v"(ssr[3]), "+v"(ssr[4]), "+v"(ssr[5]), "+v"(ssr[6]), "+v"(ssr[7]) :: "memory");
#pragma unroll
        for (int g = 0; g < 8; ++g) ssv[g] = rss_dec(ssr[g]);
#pragma unroll
        for (int ai = 0; ai < 2; ++ai)
#pragma unroll
            for (int m = 0; m < 4; ++m) { const int r = row0 + ai * 128 + m * 16; const float sc = __builtin_amdgcn_rsqf(ssv[ai * 4 + m] * (1.0f / DM) + EPS); bf16* rowp = O + (size_t)u.pm * (256 * DFF) + (size_t)(u.pn * 4 + (wc >> 1)) * (256 * 64) + (size_t)(r & 255) * 64 + (wc & 1) * 32 + 8 * fq;
#pragma unroll
                for (int bj = 0; bj < 2; ++bj) { float v[8];
#pragma unroll
                    for (int j = 0; j < 4; ++j) { const float a = fmaxf(acc[ai][bj][m][0][j] * sc, 0.f), b = fmaxf(acc[ai][bj][m][1][j] * sc, 0.f); v[j] = a * a; v[4 + j] = b * b; }
                    u32x4 w; w.x = pk2(v[0], v[1]); w.y = pk2(v[2], v[3]); w.z = pk2(v[4], v[5]); w.w = pk2(v[6], v[7]);
                    ST_POL(4, (u32x4*)(rowp + bj * 2 * (256 * 64)), w); }
                asm volatile("" ::: "memory"); }
    }
};

struct Frame {
    LAS unsigned char* lds;
    int tid, lane, wave, vcu, G;
};
typedef __attribute__((address_space(4))) const unsigned long long kau64;
__device__ __forceinline__ const float* inp(int i) { asm volatile("" : "+s"(i)); kau64* ka = (kau64*)__builtin_amdgcn_kernarg_segment_ptr(); return (const float*)(const GAS float*)ka[i]; }
__device__ __forceinline__ float* outp() { return (float*)inp(30); }
__device__ __forceinline__ unsigned char* wsp() { return (unsigned char*)inp(31); }
#define IN_X 0
#define IN_NORM1 1
#define IN_WIN 2
#define IN_WGATE 3
#define IN_BGATE 4
#define IN_KVG 5
#define IN_WUK 6
#define IN_WUV 7
#define IN_RELB 8
#define IN_WGK2 9
#define IN_BGK 10
#define IN_GLAG 11
#define IN_CONVW 12
#define IN_CONVB 13
#define IN_WRGA 14
#define IN_BRGA 15
#define IN_WRGX 16
#define IN_BRGX 17
#define IN_LAM 18
#define IN_LBP 19
#define IN_HGRNG 20
#define IN_WBRA 21
#define IN_WBRB 22
#define IN_WBRC 23
#define IN_WBRD 24
#define IN_WOUT 25
#define IN_NORM2 26
#define IN_WFF1 27
#define IN_WFF2 28
#define IN_FNORM 29

__device__ __forceinline__ int in_src_col(int n, float& sc) {
    sc = 1.0f;
    const int t = n >> 8, j = n & 255;
    switch (t) {
        case 0: case 1: return -2;
        case 2: return 384 + j;
        case 3: return 708 + j;
        case 4: return 964 + j;
        case 5: return 1220 + j;
        case 6: return 1492 + j;
        case 7: return 2004 + j;
        case 8: return 2260 + j;
        case 9: return 2772 + j;
        case 10: return 3028 + j;
        case 11: if (j < 128) return 256 + j; if (j < 192) return 640 + (j - 128); if (j < 196) return 704 + (j - 192); if (j < 212) return 1476 + (j - 196); return -1;
        case 12: return 1748 + j;
        default: return 2516 + j;
    }
}
__device__ __forceinline__ float in_col_scale(int n) { const int t = n >> 8, j = n & 255; if (t == 3) return 0.125f; if (t == 11 && j >= 192 && j < 196) return 0.0625f; return 1.0f; }
__device__ __forceinline__ int gate_src_col(int n) { const int pn = n >> 8, c = n & 255; const int bj = c >> 7, wc = (c >> 5) & 3, nn = (c >> 4) & 1, fq = (c >> 2) & 3, j = c & 3; return (2 * bj + nn) * 1024 + pn * 64 + wc * 16 + fq * 4 + j; }

template <int MODE>
__device__ __forceinline__ void transpose_item(const float* W, int ldw, int K, int N, const float* g, bf16* WT, LAS float* scr, int item, int lane) {
    const int nblk = N / 32, kb = item / nblk, nb = item % nblk, k0 = 64 * kb, n0 = 32 * nb;
    const int n = n0 + (lane & 31);
    int src; float cs = 1.0f;
    if (MODE == 0) src = n; else if (MODE == 1) { float d; src = in_src_col(n, d); cs = in_col_scale(n); } else src = gate_src_col(n);
    if (MODE == 1 && src == -2) return;
    float tv[32];
#pragma unroll
    for (int i = 0; i < 32; ++i) { const int kk = 2 * i + (lane >> 5); tv[i] = (src >= 0) ? W[(size_t)(k0 + kk) * ldw + src] : 0.f; }
#pragma unroll
    for (int i = 0; i < 32; ++i) { const int kk = 2 * i + (lane >> 5); float v = tv[i] * cs; if (g) v *= g[k0 + kk]; scr[kk * 33 + (lane & 31)] = v; }
    asm volatile("s_waitcnt lgkmcnt(0)" ::: "memory");
    const int c = lane & 7;
#pragma unroll
    for (int j = 0; j < 4; ++j) { const int nn = (lane >> 3) + 8 * j; const LAS float* s = scr + (8 * c) * 33 + nn;
        u32x4 o; o.x = pk2(s[0 * 33], s[1 * 33]); o.y = pk2(s[2 * 33], s[3 * 33]); o.z = pk2(s[4 * 33], s[5 * 33]); o.w = pk2(s[6 * 33], s[7 * 33]);
        *(u32x4*)(WT + (size_t)(n0 + nn) * K + k0 + 8 * c) = o; }
    asm volatile("s_waitcnt lgkmcnt(0)" ::: "memory");
}

__device__ __forceinline__ void phase_prologue(Frame& F) {
    LAS float* scr = (LAS float*)(F.lds + F.wave * 16384);
    const int gw = F.vcu * NWAVES + F.wave, NGW = F.G * NWAVES, lane = F.lane;
    for (int l = 0; l < DEPTH; ++l) {
        unsigned char* wb = wsp() + WS_W + (size_t)l * W_LAYER;
        const float* g1 = inp(IN_NORM1) + l * DM; const float* g2 = inp(IN_NORM2) + l * DM;
        constexpr int I_IN = (DM / 64) * (NIN / 32), I_GATE = (DM / 64) * (4096 / 32), I_BR = (256 / 64) * (DM / 32), I_OUT = (DM / 64) * (DM / 32), I_FF1 = (DM / 64) * (DFF / 32), I_FF2 = (DFF / 64) * (DM / 32);
        constexpr int NIT = I_IN + I_GATE + 3 * I_BR + I_OUT + I_FF1 + I_FF2;
        for (int it = gw; it < NIT; it += NGW) {
            int r = it;
            if (r < I_IN) { transpose_item<1>(inp(IN_WIN) + (size_t)l * DM * IN_COLS, IN_COLS, DM, NIN, g1, (bf16*)(wb + W_IN), scr, r, lane); continue; } r -= I_IN;
            if (r < I_GATE) { transpose_item<2>(inp(IN_WGATE) + (size_t)l * DM * 4096, 4096, DM, 4096, g1, (bf16*)(wb + W_GATE), scr, r, lane); continue; } r -= I_GATE;
            if (r < I_BR) { transpose_item<0>(inp(IN_WBRB) + (size_t)l * 256 * DM, DM, 256, DM, nullptr, (bf16*)(wb + W_BRB), scr, r, lane); continue; } r -= I_BR;
            if (r < I_BR) { transpose_item<0>(inp(IN_WBRC) + (size_t)l * 256 * DM, DM, 256, DM, nullptr, (bf16*)(wb + W_BRC), scr, r, lane); continue; } r -= I_BR;
            if (r < I_BR) { transpose_item<0>(inp(IN_WBRD) + (size_t)l * 256 * DM, DM, 256, DM, nullptr, (bf16*)(wb + W_BRD), scr, r, lane); continue; } r -= I_BR;
            if (r < I_OUT) { transpose_item<0>(inp(IN_WOUT) + (size_t)l * DM * DM, DM, DM, DM, nullptr, (bf16*)(wb + W_OUT), scr, r, lane); continue; } r -= I_OUT;
            if (r < I_FF1) { transpose_item<0>(inp(IN_WFF1) + (size_t)l * DM * DFF, DFF, DM, DFF, g2, (bf16*)(wb + W_FF1), scr, r, lane); continue; } r -= I_FF1;
            transpose_item<0>(inp(IN_WFF2) + (size_t)l * DFF * DM, DM, DFF, DM, nullptr, (bf16*)(wb + W_FF2), scr, r, lane);
        }
        {
            const float* win = inp(IN_WIN) + (size_t)l * DM * IN_COLS; const float* wuk = inp(IN_WUK) + (size_t)l * 4 * 64 * 128; bf16* Wq = (bf16*)(wb + W_IN);
            for (int it = gw; it < 4 * DM; it += NGW) { const int h = it / DM, k = it % DM; float a0 = 0.f, a1 = 0.f;
#pragma unroll 16
                for (int d = 0; d < 64; ++d) { const float w = win[(size_t)k * IN_COLS + h * 64 + d]; a0 += w * wuk[(h * 64 + d) * 128 + lane]; a1 += w * wuk[(h * 64 + d) * 128 + 64 + lane]; }
                const float sc = g1[k] * 0.125f; const float* kvg = inp(IN_KVG) + l * 128;
                Wq[(size_t)(h * 128 + lane) * DM + k] = (bf16)f2bf(a0 * sc * kvg[lane]); Wq[(size_t)(h * 128 + 64 + lane) * DM + k] = (bf16)f2bf(a1 * sc * kvg[64 + lane]); }
        }
        {
            const float* wuv = inp(IN_WUV) + (size_t)l * 4 * 128 * 64; const float* wbr = inp(IN_WBRA) + (size_t)l * 256 * DM; bf16* Wa = (bf16*)(wb + W_BRA);
            for (int it = gw; it < 512 * 16; it += NGW) { const int hc = it / 16, nb = it % 16, h = hc / 128, n = nb * 64 + lane; float a = 0.f;
#pragma unroll 16
                for (int d = 0; d < 64; ++d) a += wuv[(size_t)hc * 64 + d] * wbr[(size_t)(h * 64 + d) * DM + n];
                Wa[(size_t)n * 512 + hc] = (bf16)f2bf(a * inp(IN_KVG)[l * 128 + (hc & 127)]); }
        }
    }
    {
        float* tab = (float*)(wsp() + WS_TAB);
        for (int i = gw * 64 + lane; i < 512; i += NGW * 64) { const int l = i >> 8, c = i & 255; const float p0 = inp(IN_LBP)[c], p1 = inp(IN_LBP)[256 + c];
            const float mx = fmaxf(p0, p1), e0 = expf(p0 - mx), e1 = expf(p1 - mx); const float lb = (l == 0) ? 0.f : e1 / (e0 + e1);
            tab[l * 256 + c] = logf(fmaxf(lb, 1e-20f)); tab[512 + l * 256 + c] = log1pf(-lb); }
    }
    {
        rss_t* rss = (rss_t*)(wsp() + WS_RSS); bf16* xb = (bf16*)(wsp() + WS_XB); const float* x = inp(IN_X);
        for (int i = gw * 64 + lane; i < 4 * M; i += NGW * 64) rss[M + i] = 0ull;
        { rss_t* ckz = (rss_t*)(wsp() + WS_CKSS); for (int i = gw * 64 + lane; i < DEPTH * M; i += NGW * 64) ckz[i] = 0ull; }
        for (int m = gw; m < M; m += 4 * NGW) {
            f32x4 v[4][4];
#pragma unroll
            for (int u = 0; u < 4; ++u) { const f32x4* xr = (const f32x4*)(x + (size_t)(m + u * NGW) * DM) + lane;
#pragma unroll
                for (int j = 0; j < 4; ++j) v[u][j] = xr[64 * j]; }
#pragma unroll
            for (int u = 0; u < 4; ++u) { u32x2* o = (u32x2*)(xb + (size_t)(m + u * NGW) * DM) + lane; float ss = 0.f;
#pragma unroll
                for (int j = 0; j < 4; ++j) { const f32x4 t = v[u][j]; ss += (t[0] * t[0] + t[1] * t[1]) + (t[2] * t[2] + t[3] * t[3]); u32x2 w; w.x = pk2(t[0], t[1]); w.y = pk2(t[2], t[3]); o[64 * j] = w; }
                ss = wave_sum(ss); if (lane == 0) rss[m + u * NGW] = rss_enc(ss); } }
    }
}

__device__ __forceinline__ void phase_prep(Frame& F, int l) {
    const int gw = F.vcu * NWAVES + F.wave, NGW = F.G * NWAVES, lane = F.lane;
    const float* a32 = (const float*)(wsp() + WS_A32); bf16* ckv = (bf16*)(wsp() + WS_CKV); bf16* ik = (bf16*)(wsp() + WS_IK); bf16* ckvt = (bf16*)(wsp() + WS_CKVT);
    const float g0 = inp(IN_KVG)[l * 128 + 2 * lane], g1 = inp(IN_KVG)[l * 128 + 2 * lane + 1];
    for (int m0 = gw; m0 < M; m0 += 4 * NGW) {
        f32x2 vv[4]; float ikv[4];
#pragma unroll
        for (int u = 0; u < 4; ++u) { const float* r = a32 + (size_t)(m0 + u * NGW) * A32_LD; vv[u] = *(const f32x2*)(r + C_CKV + 2 * lane); ikv[u] = r[C_IK + lane]; }
#pragma unroll
        for (int u = 0; u < 4; ++u) { const int m = m0 + u * NGW; const f32x2 v = vv[u];
            const float ss = wave_sum(v.x * v.x + v.y * v.y), rs = 1.0f / sqrtf(ss * (1.0f / 128.f) + EPS);
            const unsigned cw = pk2(v.x * rs * g0, v.y * rs * g1);
            *(unsigned*)(ckv + (size_t)m * 128 + 2 * lane) = cw;
            { const int bb = m / SEQ, k = m % SEQ, kk = k & 31, pp = (k & ~31) + 8 * ((kk >> 2) & 3) + 4 * (kk >> 4) + (kk & 3);
              ckvt[((size_t)bb * 128 + 2 * lane) * SEQ + pp] = (bf16)(cw & 0xffffu); ckvt[((size_t)bb * 128 + 2 * lane + 1) * SEQ + pp] = (bf16)(cw >> 16); }
            ik[(size_t)m * 64 + lane] = (bf16)f2bf(ikv[u]); } }
}

typedef short bf16x8 __attribute__((ext_vector_type(8)));
union Frag { bf16x8 v; unsigned u[4]; u32x4 q; };
__device__ __forceinline__ unsigned cvtpk(float lo, float hi) { return pk2(lo, hi); }
__device__ __forceinline__ f32x4 mfma16(const Frag& a, const Frag& b, f32x4 c) { return __builtin_amdgcn_mfma_f32_16x16x32_bf16(a.v, b.v, c, 0, 0, 0); }
__device__ __forceinline__ float fexp(float x) { return __builtin_amdgcn_exp2f(1.44269504f * x); }
constexpr int GL_QM = 0, GL_KM = 9216, GL_QD = 18432, GL_KD = 27648, GL_QS = 36864, GL_KTT = 46080, GL_VT = 55296, GL_ST0 = 64512, GL_ST1 = 73728, GL_TOT = 82944, GL_SS = 84992, GL_DL = 85504;
struct GlaRaw { unsigned short q[8], k[8], v[8], gt[8]; float g[8]; f32x2 lr; };
__device__ __forceinline__ void gla_load_raw(GlaRaw& R, int mixer, const bf16* a16, const float* a32, int t0, int h, int d, int seg, int lane) {
    { const int r_ = lane & 15, qd_ = lane >> 4, I_ = seg & 3, vh_ = seg >> 2, cg_ = (mixer == 0 ? C_BR : C_DG) + h * 64;
#pragma unroll
      for (int j = 0; j < 4; ++j)
#pragma unroll
          for (int nbi = 0; nbi < 2; ++nbi) R.gt[2 * j + nbi] = a16[(size_t)(t0 + 16 * I_ + 4 * qd_ + j) * A16_LD + cg_ + 16 * (2 * vh_ + nbi) + r_]; }
#pragma unroll
    for (int i = 0; i < 8; ++i) { const size_t row = (size_t)(t0 + 8 * seg + i);
        if (mixer == 0) { R.q[i] = a16[row * A16_LD + C_BQ + h * 64 + d]; R.k[i] = a16[row * A16_LD + C_BK + h * 64 + d]; R.v[i] = a16[row * A16_LD + C_BV + h * 64 + d]; R.g[i] = 0.f; }
        else { R.q[i] = a16[row * A16_LD + C_DQ + h * 64 + d]; R.k[i] = 0; R.v[i] = a16[row * A16_LD + C_DI + h * 64 + d]; R.g[i] = bf2f(a16[row * A16_LD + C_DF + h * 64 + d]); } }
    if (mixer == 0) R.lr = *(const f32x2*)(a32 + (size_t)(t0 + 8 * seg + (lane >> 3)) * A32_LD + C_LR + 2 * (lane & 7)); else R.lr = (f32x2){0.f, 0.f};
}
__device__ __forceinline__ void gla_chain(LAS unsigned char* lds, int tid, int l, int mixer, int b, int h) {
    const int lane = tid & 63, wave = __builtin_amdgcn_readfirstlane(tid >> 6), d = lane, seg = wave;
    const int r = lane & 15, qd = lane >> 4, I = wave & 3, vh = wave >> 2;
    unsigned char* ws = wsp();
    const bf16* a16 = (const bf16*)(ws + WS_A16); const float* a32 = (const float*)(ws + WS_A32);
    bf16* Y = (bf16*)(ws + (mixer == 0 ? WS_YB : WS_YD));
    const float* gn = inp(mixer == 0 ? IN_GLAG : IN_HGRNG) + l * 64;
    LAS float* TOT = (LAS float*)(lds + GL_TOT); LAS float* SS = (LAS float*)(lds + GL_SS); LAS float* DL = (LAS float*)(lds + GL_DL);
    float wg[16]; float bg = 0.f;
#pragma unroll
    for (int rr = 0; rr < 16; ++rr) wg[rr] = (mixer == 0) ? inp(IN_WGK2)[(size_t)l * 4096 + rr * 256 + h * 64 + d] : 0.f;
    if (mixer == 0) bg = inp(IN_BGK)[l * 256 + h * 64 + d];
    for (int i = tid; i < 9216 / 4; i += 512) ((LAS unsigned*)(lds + GL_ST0))[i] = 0u;
    f32x4 Sreg[2] = {{0.f, 0.f, 0.f, 0.f}, {0.f, 0.f, 0.f, 0.f}};
    GlaRaw cur; gla_load_raw(cur, mixer, a16, a32, b * SEQ, h, d, seg, lane);
    for (int c = 0; c < 64; ++c) {
        const int t0 = b * SEQ + c * 64;
        LAS unsigned char* STc = lds + ((c & 1) ? GL_ST1 : GL_ST0); LAS unsigned char* STn = lds + ((c & 1) ? GL_ST0 : GL_ST1);
        float kf[8], p[8];
#pragma unroll
        for (int i = 0; i < 8; ++i) { float gi;
            if (mixer == 0) { float z = bg;
#pragma unroll
                for (int rr = 0; rr < 16; ++rr) { const int lsel = (rr & 1) ? __float_as_int(cur.lr.y) : __float_as_int(cur.lr.x); z += __int_as_float(__builtin_amdgcn_readlane(lsel, 8 * i + (rr >> 1))) * wg[rr]; }
                gi = flogsigmoid(z) * 0.0625f; kf[i] = bf2f(cur.k[i]); }
            else { gi = cur.g[i]; const float eg = fexp(gi); kf[i] = (gi > -0.03125f) ? -gi * (1.0f + gi * (0.5f + gi * (0.16666667f + gi * 0.041666667f))) : 1.0f - eg; }
            p[i] = (i == 0) ? gi : p[i - 1] + gi; }
        TOT[seg * 64 + d] = p[7];
        __syncthreads();
        { float off = 0.f, bl = 0.f, rmid = 0.f, rI = 0.f;
#pragma unroll
          for (int s = 0; s < 8; ++s) { const float tv = TOT[s * 64 + d]; bl += tv; if (s < seg) off += tv; if (s < 4) rmid += tv; if (s < (seg & ~1)) rI += tv; }
          Frag kt, vt; float ktv[8];
#pragma unroll
          for (int i = 0; i < 8; ++i) { const float bb = off + p[i], qv = bf2f(cur.q[i]), kv = kf[i]; const int o = (8 * seg + i) * 72 + d;
              ((LAS unsigned short*)(lds + GL_QM))[o] = (unsigned short)f2bf(qv * fexp(bb - rmid)); ((LAS unsigned short*)(lds + GL_KM))[o] = (unsigned short)f2bf(kv * fexp(rmid - bb));
              ((LAS unsigned short*)(lds + GL_QD))[o] = (unsigned short)f2bf(qv * fexp(bb - rI)); ((LAS unsigned short*)(lds + GL_KD))[o] = (unsigned short)f2bf(kv * fexp(rI - bb));
              ((LAS unsigned short*)(lds + GL_QS))[o] = (unsigned short)f2bf(qv * fexp(bb));
              ktv[i] = kv * fexp(bl - bb); }
#pragma unroll
          for (int i = 0; i < 8; i += 2) { kt.u[i >> 1] = cvtpk(ktv[i], ktv[i + 1]); vt.u[i >> 1] = (unsigned)cur.v[i] | ((unsigned)cur.v[i + 1] << 16); }
          *(LAS u32x4*)(lds + GL_KTT + (d * 72 + 8 * seg) * 2) = kt.q; *(LAS u32x4*)(lds + GL_VT + (d * 72 + 8 * seg) * 2) = vt.q;
          if (seg == 0) DL[d] = fexp(bl); }
        __syncthreads();
        GlaRaw nxt; if (c < 63) gla_load_raw(nxt, mixer, a16, a32, t0 + 64, h, d, seg, lane); else nxt = cur;
        f32x4 o[2] = {{0.f, 0.f, 0.f, 0.f}, {0.f, 0.f, 0.f, 0.f}};
        unsigned P[4][2];
        { Frag qd_[2], qm_[2];
#pragma unroll
          for (int ks = 0; ks < 2; ++ks) { qd_[ks].q = *(const LAS u32x4*)(lds + GL_QD + ((16 * I + r) * 72 + 8 * qd + 32 * ks) * 2); qm_[ks].q = *(const LAS u32x4*)(lds + GL_QM + ((16 * I + r) * 72 + 8 * qd + 32 * ks) * 2); }
#pragma unroll
          for (int J = 0; J < 4; ++J) { P[J][0] = 0u; P[J][1] = 0u;
              if (J <= I) { f32x4 cacc = {0.f, 0.f, 0.f, 0.f};
                  if (J == I) {
#pragma unroll
                      for (int ks = 0; ks < 2; ++ks) { Frag a; a.q = *(const LAS u32x4*)(lds + GL_KD + ((16 * J + r) * 72 + 8 * qd + 32 * ks) * 2); cacc = mfma16(a, qd_[ks], cacc); }
#pragma unroll
                      for (int j = 0; j < 4; ++j) if (4 * qd + j > r) cacc[j] = 0.f;
                  } else {
#pragma unroll
                      for (int ks = 0; ks < 2; ++ks) { Frag a; a.q = *(const LAS u32x4*)(lds + GL_KM + ((16 * J + r) * 72 + 8 * qd + 32 * ks) * 2); cacc = mfma16(a, qm_[ks], cacc); } }
                  P[J][0] = cvtpk(cacc[0], cacc[1]); P[J][1] = cvtpk(cacc[2], cacc[3]); } } }
#pragma unroll
        for (int pr = 0; pr < 2; ++pr) { if (2 * pr <= I) { Frag a; a.u[0] = P[2 * pr][0]; a.u[1] = P[2 * pr][1]; a.u[2] = P[2 * pr + 1][0]; a.u[3] = P[2 * pr + 1][1];
#pragma unroll
            for (int nbi = 0; nbi < 2; ++nbi) { const int nb = 2 * vh + nbi; Frag bb;
                const u32x2 v0 = *(const LAS u32x2*)(lds + GL_VT + ((16 * nb + r) * 72 + 32 * pr + 4 * qd) * 2), v1 = *(const LAS u32x2*)(lds + GL_VT + ((16 * nb + r) * 72 + 32 * pr + 16 + 4 * qd) * 2);
                bb.u[0] = v0.x; bb.u[1] = v0.y; bb.u[2] = v1.x; bb.u[3] = v1.y;
                o[nbi] = mfma16(a, bb, o[nbi]); } } }
#pragma unroll
        for (int ks = 0; ks < 2; ++ks) { Frag qs; qs.q = *(const LAS u32x4*)(lds + GL_QS + ((16 * I + r) * 72 + 8 * qd + 32 * ks) * 2);
#pragma unroll
            for (int nbi = 0; nbi < 2; ++nbi) { const int nb = 2 * vh + nbi; Frag bb; bb.q = *(const LAS u32x4*)(STc + ((16 * nb + r) * 72 + 8 * qd + 32 * ks) * 2); o[nbi] = mfma16(qs, bb, o[nbi]); } }
        { float s4[4];
#pragma unroll
          for (int j = 0; j < 4; ++j) { s4[j] = o[0][j] * o[0][j] + o[1][j] * o[1][j]; s4[j] += __shfl_xor(s4[j], 1); s4[j] += __shfl_xor(s4[j], 2); s4[j] += __shfl_xor(s4[j], 4); s4[j] += __shfl_xor(s4[j], 8); }
          if (r == 0) {
#pragma unroll
              for (int j = 0; j < 4; ++j) SS[vh * 64 + 16 * I + 4 * qd + j] = s4[j]; } }
        { const int db = wave >> 1;
          const f32x4 dlv = *(const LAS f32x4*)(DL + 16 * db + 4 * qd);
#pragma unroll
          for (int nbi = 0; nbi < 2; ++nbi) { const int nb = 2 * (wave & 1) + nbi; f32x4 cacc = Sreg[nbi] * dlv;
#pragma unroll
              for (int ks = 0; ks < 2; ++ks) { Frag a, bb; a.q = *(const LAS u32x4*)(lds + GL_KTT + ((16 * db + r) * 72 + 8 * qd + 32 * ks) * 2); bb.q = *(const LAS u32x4*)(lds + GL_VT + ((16 * nb + r) * 72 + 8 * qd + 32 * ks) * 2); cacc = mfma16(a, bb, cacc); }
              Sreg[nbi] = cacc;
              u32x2 w; w.x = cvtpk(cacc[0], cacc[1]); w.y = cvtpk(cacc[2], cacc[3]);
              *(LAS u32x2*)(STn + ((16 * nb + r) * 72 + 16 * db + 4 * qd) * 2) = w; } }
        __syncthreads();
#pragma unroll
        for (int j = 0; j < 4; ++j) { const int il = 16 * I + 4 * qd + j; const float rs = __builtin_amdgcn_rsqf((SS[il] + SS[64 + il]) * (1.0f / 64.f) + EPS); const size_t row = (size_t)(t0 + il);
#pragma unroll
            for (int nbi = 0; nbi < 2; ++nbi) { const int v = 16 * (2 * vh + nbi) + r; const float gate = bf2f(cur.gt[2 * j + nbi]);
                Y[row * 256 + h * 64 + v] = (bf16)f2bf(o[nbi][j] * rs * gn[v] * gate); } }
        cur = nxt;
    }
    __syncthreads();
}

constexpr int RG_XCB = 0, RG_WAT = 9216, RG_WXT = 18432, RG_AF = 27648, RG_IF = 44032, RG_SEGA = 60416, RG_SEGH = 62464, RG_CARRY = 64512;
__device__ __forceinline__ void rglru_chain(LAS unsigned char* lds, int tid, int l, int b, int blk) {
    const int lane = tid & 63, wave = __builtin_amdgcn_readfirstlane(tid >> 6), ch = lane, seg = wave, gc = blk * 64 + ch;
    const int r = lane & 15, qd = lane >> 4, mb = wave & 3, nh = wave >> 2;
    unsigned char* ws = wsp();
    const bf16* a16 = (const bf16*)(ws + WS_A16); const float* a32 = (const float*)(ws + WS_A32); bf16* Y = (bf16*)(ws + WS_YC);
    LAS float* AF = (LAS float*)(lds + RG_AF); LAS float* IFm = (LAS float*)(lds + RG_IF); LAS float* SEGA = (LAS float*)(lds + RG_SEGA); LAS float* SEGH = (LAS float*)(lds + RG_SEGH); LAS float* CARRY = (LAS float*)(lds + RG_CARRY);
    { const float* wa = inp(IN_WRGA) + ((size_t)l * 4 + blk) * 4096; const float* wx = inp(IN_WRGX) + ((size_t)l * 4 + blk) * 4096;
      for (int e = tid; e < 4096; e += 512) { const int i = e >> 6, j = e & 63; ((LAS unsigned short*)(lds + RG_WAT))[j * 72 + i] = (unsigned short)f2bf(wa[e]); ((LAS unsigned short*)(lds + RG_WXT))[j * 72 + i] = (unsigned short)f2bf(wx[e]); }
      if (tid < 128) CARRY[tid] = 0.f; }
    float cw[4];
#pragma unroll
    for (int j = 0; j < 4; ++j) cw[j] = inp(IN_CONVW)[l * 1024 + j * 256 + gc];
    const float cb = inp(IN_CONVB)[l * 256 + gc];
    float ba2[2], bx2[2], sp2[2];
#pragma unroll
    for (int nbi = 0; nbi < 2; ++nbi) { const int j = blk * 64 + 16 * (2 * nh + nbi) + r; ba2[nbi] = inp(IN_BRGA)[l * 256 + j]; bx2[nbi] = inp(IN_BRGX)[l * 256 + j];
        const float nl = -inp(IN_LAM)[l * 256 + j]; sp2[nbi] = fmaxf(nl, 0.f) + log1pf(expf(-fabsf(nl))); }
    __syncthreads();
    float xn[11]; unsigned short cyn[8];
#define RG_LOAD(c_) do { const int tl_ = (c_) * 64 + 8 * seg; _Pragma("unroll") for (int i = 0; i < 11; ++i) { const int t = tl_ - 3 + i; xn[i] = (t >= 0) ? bf2f(a16[(size_t)(b * SEQ + t) * A16_LD + C_CX + gc]) : 0.f; } \
        _Pragma("unroll") for (int i = 0; i < 8; ++i) cyn[i] = a16[(size_t)(b * SEQ + tl_ + i) * A16_LD + C_CY + gc]; } while (0)
    RG_LOAD(0);
    for (int c = 0; c < 64; ++c) {
        const int tl0 = c * 64 + 8 * seg;
        float x[11], xc[8]; unsigned short cy[8];
#pragma unroll
        for (int i = 0; i < 11; ++i) x[i] = xn[i];
#pragma unroll
        for (int i = 0; i < 8; ++i) cy[i] = cyn[i];
        if (c < 63) RG_LOAD(c + 1);
#pragma unroll
        for (int i = 0; i < 8; ++i) { xc[i] = cb + cw[0] * x[i] + cw[1] * x[i + 1] + cw[2] * x[i + 2] + cw[3] * x[i + 3]; ((LAS unsigned short*)(lds + RG_XCB))[(8 * seg + i) * 72 + ch] = (unsigned short)f2bf(xc[i]); }
        __syncthreads();
#pragma unroll
        for (int nbi = 0; nbi < 2; ++nbi) { const int nb = 2 * nh + nbi; f32x4 za = {0.f, 0.f, 0.f, 0.f}, zx = {0.f, 0.f, 0.f, 0.f};
#pragma unroll
            for (int ks = 0; ks < 2; ++ks) { Frag a, wa, wx; a.q = *(const LAS u32x4*)(lds + RG_XCB + ((16 * mb + r) * 72 + 8 * qd + 32 * ks) * 2);
                wa.q = *(const LAS u32x4*)(lds + RG_WAT + ((16 * nb + r) * 72 + 8 * qd + 32 * ks) * 2); wx.q = *(const LAS u32x4*)(lds + RG_WXT + ((16 * nb + r) * 72 + 8 * qd + 32 * ks) * 2);
                za = mfma16(a, wa, za); zx = mfma16(a, wx, zx); }
#pragma unroll
            for (int j = 0; j < 4; ++j) { const int t = 16 * mb + 4 * qd + j; const float rg = fsigmoid(za[j] + ba2[nbi]), ig = fsigmoid(zx[j] + bx2[nbi]); const float la = -8.0f * rg * sp2[nbi];
                const float ea = fexp(la), y2 = 2.0f * la; const float om = (y2 > -0.25f) ? -y2 * (1.0f + y2 * (0.5f + y2 * (0.16666667f + y2 * (0.041666667f + y2 * 0.0083333333f)))) : 1.0f - ea * ea;
                AF[t * 64 + 16 * nb + r] = ea; IFm[t * 64 + 16 * nb + r] = __builtin_amdgcn_sqrtf(fmaxf(om, 0.f)) * ig; } }
        __syncthreads();
        float hl[8], al[8]; { float H = 0.f, A = 1.f;
#pragma unroll
          for (int i = 0; i < 8; ++i) { const float a = AF[(8 * seg + i) * 64 + ch], u = IFm[(8 * seg + i) * 64 + ch] * xc[i]; H = a * H + u; A *= a; hl[i] = H; al[i] = A; }
          SEGA[seg * 64 + ch] = A; SEGH[seg * 64 + ch] = H; }
        __syncthreads();
        float hin = CARRY[(c & 1) * 64 + ch];
#pragma unroll
        for (int s = 0; s < 7; ++s) if (s < seg) hin = SEGA[s * 64 + ch] * hin + SEGH[s * 64 + ch];
        float hlast = 0.f;
#pragma unroll
        for (int i = 0; i < 8; ++i) { const float hv = hl[i] + al[i] * hin; hlast = hv; const size_t row = (size_t)(b * SEQ + tl0 + i);
            Y[row * 256 + gc] = (bf16)f2bf(hv * bf2f(cy[i])); }
        if (seg == 7) CARRY[((c + 1) & 1) * 64 + ch] = hlast;
    }
    __syncthreads();
}
__device__ __forceinline__ int t5_bucket(int n) {
    if (n < 16) return n;
    int b = 16;
    b += (n >= 19) + (n >= 21) + (n >= 24) + (n >= 27) + (n >= 31) + (n >= 35) + (n >= 40) + (n >= 46) + (n >= 52) + (n >= 59) + (n >= 67) + (n >= 77) + (n >= 87) + (n >= 99) + (n >= 113);
    return b;
}

#ifndef DSA_SPARSE
#define DSA_SPARSE 1
#endif
constexpr int HP = 257;
constexpr int DS_H = 0;
constexpr int SP = 130;
constexpr int DS_SEL = 49920;
constexpr int DS_TIE = 33280;
constexpr int DS_H2 = 66560;
constexpr int DS_BUF0 = 66560, DS_BUF1 = 0;
constexpr int DS_KTB = 17408, DS_STG = 35840;
constexpr int WREG = 10752;
constexpr int DS_LUT = 66560 + 4 * WREG;
constexpr int DS_QS = DS_LUT + 2048;
constexpr int DS_ITEM = DS_QS + 1024;
constexpr int DS_RSK = DS_ITEM + 64;
constexpr int CW_QUEUE = 8192;
__device__ __forceinline__ float relu_i(float x) { const int b = __float_as_int(x); return __int_as_float(b > 0 ? b : 0); }
__device__ __forceinline__ unsigned key16(float s) {
    s = s + 0.0f;
    const _Float16 hf = (_Float16)s; unsigned short hb = __builtin_bit_cast(unsigned short, hf);
    return (hb & 0x8000u) ? (unsigned)(hb ^ 0xFFFFu) : (unsigned)(hb | 0x8000u);
}
typedef _Float16 f16x2_t __attribute__((ext_vector_type(2)));
typedef short s16x2_t __attribute__((ext_vector_type(2)));
__device__ __forceinline__ unsigned keys2(float a, float b) {
    const f16x2_t hv = {(_Float16)a, (_Float16)b}; const unsigned h = __builtin_bit_cast(unsigned, hv);
    const s16x2_t sg = __builtin_bit_cast(s16x2_t, h) >> 15;
    return h ^ (__builtin_bit_cast(unsigned, sg) | 0x80008000u);
}
__device__ __forceinline__ unsigned wave_suffix_sum(unsigned v, int lane) {
    unsigned s = v;
    s += (unsigned)__builtin_amdgcn_update_dpp(0, (int)s, 0x101, 0xf, 0xf, true);
    s += (unsigned)__builtin_amdgcn_update_dpp(0, (int)s, 0x102, 0xf, 0xf, true);
    s += (unsigned)__builtin_amdgcn_update_dpp(0, (int)s, 0x104, 0xf, 0xf, true);
    s += (unsigned)__builtin_amdgcn_update_dpp(0, (int)s, 0x108, 0xf, 0xf, true);
    const unsigned t1 = (unsigned)__builtin_amdgcn_readlane((int)s, 16), t2 = (unsigned)__builtin_amdgcn_readlane((int)s, 32), t3 = (unsigned)__builtin_amdgcn_readlane((int)s, 48);
    const int row = lane >> 4;
    return s + (row == 0 ? t1 + t2 + t3 : (row == 1 ? t2 + t3 : (row == 2 ? t3 : 0u)));
}
__device__ __forceinline__ void dsa_find_bin(const LAS unsigned* hrow, int lane, unsigned need, unsigned& B, unsigned& above, unsigned& atB) {
    u32x4 c4;
    c4.x = hrow[4 * lane] + hrow[HP + 4 * lane]; c4.y = hrow[4 * lane + 1] + hrow[HP + 4 * lane + 1]; c4.z = hrow[4 * lane + 2] + hrow[HP + 4 * lane + 2]; c4.w = hrow[4 * lane + 3] + hrow[HP + 4 * lane + 3];
    const unsigned tot = c4.x + c4.y + c4.z + c4.w, suf = wave_suffix_sum(tot, lane);
    const unsigned excl = suf - tot;
    const bool mine = (suf >= need) && (excl < need);
    unsigned b = 0, ab = 0, at = 0;
    if (mine) { unsigned acc = excl; const unsigned cc[4] = {c4.x, c4.y, c4.z, c4.w};
#pragma unroll
        for (int k = 3; k >= 0; --k) { if (acc < need && acc + cc[k] >= need) { b = 4 * lane + k; ab = acc; at = cc[k]; } acc += cc[k]; } }
    const unsigned long long mm = __ballot(mine); const int src = mm ? (int)__builtin_ctzll(mm) : 0;
    B = (unsigned)__builtin_amdgcn_readlane((int)b, src); above = (unsigned)__builtin_amdgcn_readlane((int)ab, src); atB = (unsigned)__builtin_amdgcn_readlane((int)at, src);
}
__device__ __forceinline__ void dsa_select16(LAS unsigned char* lds, const bf16* ikb, const bf16* a16, const float* a32, size_t q0h, int p0h, int half, int NT, int tid) {
    const int lane = tid & 63, wave = __builtin_amdgcn_readfirstlane(tid >> 6), r = lane & 15, qd = lane >> 4;
    LAS unsigned* H = (LAS unsigned*)(lds + DS_H); LAS unsigned* SEL = (LAS unsigned*)(lds + DS_SEL) + half * 16 * SP; LAS unsigned* TIE = (LAS unsigned*)(lds + DS_TIE) + half * 16 * SP; LAS unsigned* QS = (LAS unsigned*)(lds + DS_QS);
    LAS unsigned* Hme = H + (r * 2 + (qd & 1)) * HP;
    LAS unsigned* H2 = (LAS unsigned*)(lds + DS_H2); LAS unsigned* Hme2 = H2 + (r * 2 + (qd & 1)) * HP;
    const int pos = p0h + r;
    const int nrem = NT - wave;
    const int lim = pos - (16 * wave + 4 * qd);
    LAS unsigned* SELw = SEL + r * SP + (wave >> 1); LAS unsigned* TIEw = TIE + r * SP + (wave >> 1); const int shw = 16 * (wave & 1) + 4 * qd;
    unsigned KR[32][2];
    {
        Frag BQ[4][2]; float wq[4];
        { const size_t row = q0h + r;
#pragma unroll
          for (int h = 0; h < 4; ++h) { wq[h] = a32[row * A32_LD + C_IW + h];
#pragma unroll
              for (int ks = 0; ks < 2; ++ks) BQ[h][ks].q = *(const u32x4*)(a16 + row * A16_LD + C_IQ + h * 64 + 8 * qd + 32 * ks); } }
        Frag an[3][2];
        const bf16* pa = ikb + (size_t)(16 * wave + r) * 64 + 8 * qd;
#pragma unroll
        for (int pf = 0; pf < 3; ++pf) { if (8 * pf < nrem) {
#pragma unroll
            for (int ks = 0; ks < 2; ++ks) an[pf][ks].q = *(const u32x4*)(pa + (size_t)pf * (8 * 16 * 64) + 32 * ks); } }
#pragma unroll
        for (int it = 0; it < 32; ++it) { KR[it][0] = 0u; KR[it][1] = 0u;
            if (8 * it < nrem) {
                Frag a[2]; a[0] = an[it % 3][0]; a[1] = an[it % 3][1];
                if (8 * (it + 3) < nrem) { unsigned eo = (unsigned)(it + 3) * (8 * 16 * 64); asm volatile("" : "+v"(eo));
#pragma unroll
                  for (int ks = 0; ks < 2; ++ks) an[it % 3][ks].q = *(const u32x4*)(pa + eo + 32 * ks); }
                f32x4 sc = {0.f, 0.f, 0.f, 0.f};
#pragma unroll
                for (int h = 0; h < 4; ++h) { f32x4 acc = {0.f, 0.f, 0.f, 0.f}; acc = mfma16(a[0], BQ[h][0], acc); acc = mfma16(a[1], BQ[h][1], acc);
#pragma unroll
                    for (int j = 0; j < 4; ++j) sc[j] += wq[h] * relu_i(acc[j]); }
                unsigned k01 = keys2(sc[0], sc[1]), k23 = keys2(sc[2], sc[3]);
                if (128 * it + 16 * wave + 15 > p0h) { const int dd = lim - 128 * it;
                    k01 &= (dd >= 1) ? 0xFFFFFFFFu : (dd >= 0 ? 0xFFFFu : 0u); k23 &= (dd >= 3) ? 0xFFFFFFFFu : (dd >= 2 ? 0xFFFFu : 0u); }
                __hip_atomic_fetch_add(Hme + ((k01 >> 8) & 255u), 1u, __ATOMIC_RELAXED, __HIP_MEMORY_SCOPE_WORKGROUP); __hip_atomic_fetch_add(Hme + (k01 >> 24), 1u, __ATOMIC_RELAXED, __HIP_MEMORY_SCOPE_WORKGROUP);
                __hip_atomic_fetch_add(Hme + ((k23 >> 8) & 255u), 1u, __ATOMIC_RELAXED, __HIP_MEMORY_SCOPE_WORKGROUP); __hip_atomic_fetch_add(Hme + (k23 >> 24), 1u, __ATOMIC_RELAXED, __HIP_MEMORY_SCOPE_WORKGROUP);
                KR[it][0] = k01; KR[it][1] = k23; } }
    }
    __syncthreads();
#pragma unroll 1
    for (int qi = wave * 2; qi < wave * 2 + 2; ++qi) { unsigned B, ab, at; dsa_find_bin(H + qi * 2 * HP, lane, (unsigned)TOPK, B, ab, at); if (lane == 0) { QS[qi] = B; QS[32 + qi] = ab; } }
    __syncthreads();
    { const unsigned b1 = QS[r];
#pragma unroll
      for (int it = 0; it < 32; ++it) { if (8 * it < nrem) { const unsigned kw[2] = {KR[it][0], KR[it][1]};
#pragma unroll
          for (int j = 0; j < 4; ++j) { const unsigned k = (kw[j >> 1] >> (16 * (j & 1))) & 0xffffu; if ((k >> 8) == b1) __hip_atomic_fetch_add(Hme2 + (k & 255u), 1u, __ATOMIC_RELAXED, __HIP_MEMORY_SCOPE_WORKGROUP); } } }
      for (int i = tid; i < 32 * HP / 4; i += 512) ((LAS u32x4*)(lds + DS_H))[i] = (u32x4){0u, 0u, 0u, 0u}; }
    __syncthreads();
#pragma unroll 1
    for (int qi = wave * 2; qi < wave * 2 + 2; ++qi) { const unsigned ab1 = QS[32 + qi], b1q = QS[qi]; unsigned B, ab, at; dsa_find_bin(H2 + qi * 2 * HP, lane, (unsigned)TOPK - ab1, B, ab, at);
        if (lane == 0) { const unsigned rt = (unsigned)TOPK - ab1 - ab; QS[64 + qi] = (b1q << 8) | B; QS[96 + qi] = rt; QS[128 + qi] = (at == rt) ? 1u : 0u; } }
    __syncthreads();
    { const unsigned tau = QS[64 + r]; const bool allt = QS[128 + r] != 0u;
#pragma unroll
      for (int it = 0; it < 32; ++it) { if (8 * it < nrem) { unsigned selb = 0u, tieb = 0u; const unsigned kw[2] = {KR[it][0], KR[it][1]};
#pragma unroll
          for (int j = 0; j < 4; ++j) { const unsigned k = (kw[j >> 1] >> (16 * (j & 1))) & 0xffffu; const bool gt = k > tau, eq = (k == tau); const bool s1 = gt | (eq & allt); selb |= (s1 ? 1u : 0u) << j; tieb |= ((eq && !s1) ? 1u : 0u) << j; }
          __hip_atomic_fetch_or(SELw + 4 * it, selb << shw, __ATOMIC_RELAXED, __HIP_MEMORY_SCOPE_WORKGROUP); if (tieb) __hip_atomic_fetch_or(TIEw + 4 * it, tieb << shw, __ATOMIC_RELAXED, __HIP_MEMORY_SCOPE_WORKGROUP); } }
      for (int i = tid; i < 32 * HP / 4; i += 512) ((LAS u32x4*)(lds + DS_H2))[i] = (u32x4){0u, 0u, 0u, 0u}; }
    __syncthreads();
#pragma unroll 1
    for (int qi = wave * 2; qi < wave * 2 + 2; ++qi) { if (QS[128 + qi] == 0u) { const unsigned rem = QS[96 + qi];
        unsigned w0 = TIE[qi * SP + 2 * lane], w1 = TIE[qi * SP + 2 * lane + 1]; const unsigned c0 = __popc(w0), c1 = __popc(w1);
        unsigned pre = c0 + c1;
#pragma unroll
        for (int o = 1; o < 64; o <<= 1) { const unsigned t = __shfl_up(pre, o); if (lane >= o) pre += t; }
        unsigned before = pre - (c0 + c1);
        if (before < rem && (c0 + c1) != 0u) { unsigned quota = rem - before;
            unsigned k0 = 0u; { unsigned bits = w0; while (bits && quota) { const unsigned lowb = bits & (0u - bits); k0 |= lowb; bits ^= lowb; --quota; } }
            unsigned k1 = 0u; { unsigned bits = w1; while (bits && quota) { const unsigned lowb = bits & (0u - bits); k1 |= lowb; bits ^= lowb; --quota; } }
            if (k0) SEL[qi * SP + 2 * lane] |= k0; if (k1) SEL[qi * SP + 2 * lane + 1] |= k1; } } }
    __syncthreads();
}

typedef short s16x4 __attribute__((ext_vector_type(4)));
__device__ __forceinline__ u32x2 lds_tr16(const LAS unsigned char* p) { const s16x4 v = __builtin_amdgcn_ds_read_tr16_b64_v4i16((LAS s16x4*)p); return __builtin_bit_cast(u32x2, v); }
__device__ __forceinline__ void dsa_sparse_query(LAS unsigned char* wl, const LAS unsigned* selrow, const LAS float* LUT, const bf16* ckv, const rss_t* ckss, const bf16* a16, bf16* olat, size_t row, int pos, int lane) {
    const int r = lane & 15, qd = lane >> 4;
    LAS unsigned char* G = wl; LAS unsigned short* IDX = (LAS unsigned short*)(wl + 8704); LAS unsigned short* IDX2 = (LAS unsigned short*)(wl + 9216); LAS float* RSQ = (LAS float*)(wl + 9728);
    { unsigned w0 = selrow[2 * lane], w1 = selrow[2 * lane + 1]; const int cnt = __popc(w0) + __popc(w1); int pre = cnt;
#pragma unroll
      for (int o = 1; o < 64; o <<= 1) { const int t = __shfl_up(pre, o); if (lane >= o) pre += t; }
      int p = pre - cnt;
      while (w0) { const int bpos = __builtin_ctz(w0); w0 &= w0 - 1u; if (p < TOPK) { const unsigned short kv_ = (unsigned short)(64 * lane + bpos); IDX[p] = kv_; IDX2[(p & ~31) + 8 * (p & 3) + ((p & 31) >> 2)] = kv_; } ++p; }
      while (w1) { const int bpos = __builtin_ctz(w1); w1 &= w1 - 1u; if (p < TOPK) { const unsigned short kv_ = (unsigned short)(64 * lane + 32 + bpos); IDX[p] = kv_; IDX2[(p & ~31) + 8 * (p & 3) + ((p & 31) >> 2)] = kv_; } ++p; } }
    asm volatile("s_waitcnt lgkmcnt(0)" ::: "memory");
#pragma unroll
    for (int i = 0; i < 4; ++i) { const int p_ = lane + 64 * i; const unsigned key_ = IDX[p_]; RSQ[p_] = __builtin_amdgcn_rsqf(rss_dec(ckss[key_]) * (1.0f / 128.f) + EPS) * 1.44269504f; }
    Frag qf[4];
#pragma unroll
    for (int ks = 0; ks < 4; ++ks) { qf[ks].q = (u32x4){0u, 0u, 0u, 0u}; if (r < 4) qf[ks].q = *(const u32x4*)(a16 + row * A16_LD + C_QL + r * 128 + 8 * qd + 32 * ks); }
    f32x4 O[8];
#pragma unroll
    for (int mb = 0; mb < 8; ++mb) O[mb] = (f32x4){0.f, 0.f, 0.f, 0.f};
    float mrun = -1e30f, lsum = 0.f;
    u32x4 gA[8], gB[8];
#define SP_GATHER(G_, c_) do { const u32x4 kq_ = *(const LAS u32x4*)(IDX2 + 32 * (c_) + 8 * (lane >> 4)); const unsigned kk_[4] = {kq_.x, kq_.y, kq_.z, kq_.w}; \
        _Pragma("unroll") for (int i_ = 0; i_ < 8; ++i_) { const unsigned key_ = (kk_[i_ >> 1] >> (16 * (i_ & 1))) & 0xffffu; G_[i_] = *(const u32x4*)(ckv + (size_t)key_ * 128 + 8 * (lane & 15)); } } while (0)
    asm volatile("s_waitcnt lgkmcnt(0)" ::: "memory");
    SP_GATHER(gA, 0); SP_GATHER(gB, 1);
#pragma unroll 1
    for (int c2 = 0; c2 < 8; c2 += 2)
#pragma unroll
    for (int cc = 0; cc < 2; ++cc) { const int c = c2 + cc;
#pragma unroll
        for (int i = 0; i < 8; ++i) { const int pc = lane + 64 * i; *(LAS u32x4*)(G + ((pc >> 4) * 136 + 8 * (pc & 15)) * 2) = cc ? gB[i] : gA[i]; }
        if (c + 2 < 8) { if (cc) SP_GATHER(gB, c + 2); else SP_GATHER(gA, c + 2); }
        const u32x2 kw0 = *(const LAS u32x2*)(IDX + 32 * c + 4 * qd), kw1 = *(const LAS u32x2*)(IDX + 32 * c + 16 + 4 * qd);
        f32x4 S[2];
#pragma unroll
        for (int T = 0; T < 2; ++T) { Frag ak[4]; S[T] = (f32x4){0.f, 0.f, 0.f, 0.f};
#pragma unroll
            for (int ks = 0; ks < 4; ++ks) ak[ks].q = *(const LAS u32x4*)(G + ((16 * T + r) * 136 + 8 * qd + 32 * ks) * 2);
#pragma unroll
            for (int ks = 0; ks < 4; ++ks) S[T] = mfma16(ak[ks], qf[ks], S[T]); }
        float l2[8]; float mx = -1e30f; float rsl[8];
        { const f32x4 ra = *(const LAS f32x4*)(RSQ + 32 * c + 4 * qd), rb = *(const LAS f32x4*)(RSQ + 32 * c + 16 + 4 * qd);
#pragma unroll
          for (int j = 0; j < 4; ++j) { rsl[j] = ra[j]; rsl[4 + j] = rb[j]; } }
        { const unsigned kk[4] = {kw0.x, kw0.y, kw1.x, kw1.y};
#pragma unroll
          for (int e = 0; e < 8; ++e) { const int key = (int)((kk[e >> 1] >> (16 * (e & 1))) & 0xffffu); int dist = pos - key; dist = dist < 0 ? 0 : (dist > 127 ? 127 : dist);
              const float v = S[e >> 2][e & 3] * rsl[e] + LUT[dist * 4 + (r & 3)]; l2[e] = v; mx = fmaxf(mx, v); } }
        mx = fmaxf(mx, __shfl_xor(mx, 16)); mx = fmaxf(mx, __shfl_xor(mx, 32));
        const float mnew = fmaxf(mrun, mx), alpha = __builtin_amdgcn_exp2f(mrun - mnew); mrun = mnew;
        float pv[8]; float ps = 0.f;
#pragma unroll
        for (int e = 0; e < 8; ++e) { pv[e] = __builtin_amdgcn_exp2f(l2[e] - mnew); ps += pv[e]; }
        lsum = lsum * alpha + ps;
#pragma unroll
        for (int e = 0; e < 8; ++e) pv[e] *= rsl[e] * 0.69314718f;
        Frag pb; pb.u[0] = pk2(pv[0], pv[1]); pb.u[1] = pk2(pv[2], pv[3]); pb.u[2] = pk2(pv[4], pv[5]); pb.u[3] = pk2(pv[6], pv[7]);
#pragma unroll
        for (int m4 = 0; m4 < 8; m4 += 4) { Frag av[4];
#pragma unroll
            for (int mi = 0; mi < 4; ++mi) { const int mb = m4 + mi; const u32x2 t0 = lds_tr16(G + ((4 * qd + (r >> 2)) * 136 + 16 * mb + 4 * (r & 3)) * 2), t1 = lds_tr16(G + ((16 + 4 * qd + (r >> 2)) * 136 + 16 * mb + 4 * (r & 3)) * 2);
                av[mi].u[0] = t0.x; av[mi].u[1] = t0.y; av[mi].u[2] = t1.x; av[mi].u[3] = t1.y; }
#pragma unroll
            for (int mi = 0; mi < 4; ++mi) { O[m4 + mi] = O[m4 + mi] * alpha; O[m4 + mi] = mfma16(av[mi], pb, O[m4 + mi]); } }
        asm volatile("s_waitcnt lgkmcnt(0)" ::: "memory");
    }
#undef SP_GATHER
    lsum += __shfl_xor(lsum, 16); lsum += __shfl_xor(lsum, 32);
    const float inv = 1.0f / lsum;
    if (r < 4) {
#pragma unroll
        for (int mb = 0; mb < 8; ++mb) { u32x2 w; w.x = pk2(O[mb][0] * inv, O[mb][1] * inv); w.y = pk2(O[mb][2] * inv, O[mb][3] * inv);
            *(u32x2*)(olat + row * 512 + r * 128 + 16 * mb + 4 * qd) = w; } }
}
__device__ __forceinline__ void dsa_process_item(LAS unsigned char* lds, int tid_in, int l, int b, int qt) {
    int tid = tid_in; asm volatile("" : "+v"(tid));
    const int lane = tid & 63, wave = __builtin_amdgcn_readfirstlane(tid >> 6), r = lane & 15, qd = lane >> 4;
    unsigned char* ws = wsp();
    const bf16* a16 = (const bf16*)(ws + WS_A16); const float* a32 = (const float*)(ws + WS_A32);
    const bf16* ckv = (const bf16*)(ws + WS_CKV) + (size_t)b * SEQ * 128; const rss_t* ckss = (const rss_t*)(ws + WS_CKSS) + (size_t)l * M + (size_t)b * SEQ; const bf16* ikb = (const bf16*)(ws + WS_IK) + (size_t)b * SEQ * 64;
    bf16* olat = (bf16*)(ws + WS_OLAT);
    const int p0 = qt * 32; const size_t q0 = (size_t)b * SEQ + p0;
    LAS unsigned* H = (LAS unsigned*)(lds + DS_H); LAS unsigned* SEL = (LAS unsigned*)(lds + DS_SEL); LAS unsigned* TIE = (LAS unsigned*)(lds + DS_TIE); LAS unsigned* QS = (LAS unsigned*)(lds + DS_QS);
    LAS float* LUT = (LAS float*)(lds + DS_LUT);
    for (int i = tid; i < 66560 / 16; i += 512) ((LAS u32x4*)(lds + DS_H))[i] = (u32x4){0u, 0u, 0u, 0u};
    if (p0 >= TOPK) for (int i = tid; i < 32 * HP / 4; i += 512) ((LAS u32x4*)(lds + DS_H2))[i] = (u32x4){0u, 0u, 0u, 0u};
    __syncthreads();
    const int NT = p0 / 16 + 2;
    if (p0 < TOPK) {
        for (int i = tid; i < 32 * 128; i += 512) { const int q = i >> 7, w = i & 127, pos = p0 + q; const int lo = 32 * w; unsigned bits = 0u;
            if (pos >= lo + 31) bits = 0xFFFFFFFFu; else if (pos >= lo) bits = (2u << (pos - lo)) - 1u;
            SEL[q * SP + w] = bits; }
        __syncthreads();
    } else {
#pragma unroll 1
        for (int half = 0; half < 2; ++half) dsa_select16(lds, ikb, a16, a32, q0 + 16 * half, p0 + 16 * half, half, NT, tid);
    }
    if (tid < 128) { const int bk = t5_bucket(tid);
#pragma unroll
        for (int hh = 0; hh < 4; ++hh) LUT[tid * 4 + hh] = inp(IN_RELB)[bk * 4 + hh] * 1.44269504f; }
#if DSA_SPARSE
    if (p0 >= 2048) {
        __syncthreads();
        LAS unsigned char* wl = lds + (wave < 4 ? wave * WREG : 66560 + (wave - 4) * WREG);
#pragma unroll 1
#ifdef PROBE_SP2
        for (int qi = 0; qi < 4; ++qi) { const int qq = wave * 4 + qi; dsa_sparse_query(wl, SEL + qq * SP, LUT, ckv, ckss, a16, olat, q0 + qq, p0 + qq, lane); }
#endif
        for (int qi = 0; qi < 4; ++qi) { const int qq = wave * 4 + qi; dsa_sparse_query(wl, SEL + qq * SP, LUT, ckv, ckss, a16, olat, q0 + qq, p0 + qq, lane); }
    } else
#endif
    {
        const int h = wave & 3, qh = wave >> 2, qq = 16 * qh + r; const int pos = p0 + qq; const size_t row = q0 + qq;
        Frag bq[4];
#pragma unroll
        for (int ks = 0; ks < 4; ++ks) bq[ks].q = *(const u32x4*)(a16 + row * A16_LD + C_QL + h * 128 + 8 * qd + 32 * ks);
        const float bfar = inp(IN_RELB)[31 * 4 + h] * 1.44269504f;
        f32x4 O[8];
#pragma unroll
        for (int mb = 0; mb < 8; ++mb) O[mb] = (f32x4){0.f, 0.f, 0.f, 0.f};
        float mrun = -1e30f, lsum = 0.f;
        const int NS = p0 / 64 + 1;
        LAS float* RSK = (LAS float*)(lds + DS_RSK);
        for (int k_ = tid; k_ < 64 * NS; k_ += 512) RSK[k_] = __builtin_amdgcn_rsqf(rss_dec(ckss[k_ < SEQ ? k_ : SEQ - 1]) * (1.0f / 128.f) + EPS) * 1.44269504f;
        u32x4 kreg[2];
#define DSA_LOAD(s_) do { _Pragma("unroll") for (int i_ = 0; i_ < 2; ++i_) { const int c_ = tid + 512 * i_; \
            int kr_ = 64 * (s_) + (c_ >> 4); kr_ = kr_ < SEQ ? kr_ : SEQ - 1; kreg[i_] = *(const u32x4*)(ckv + (size_t)kr_ * 128 + 8 * (c_ & 15)); } } while (0)
#define DSA_STORE(base_) do { _Pragma("unroll") for (int i_ = 0; i_ < 2; ++i_) { const int c_ = tid + 512 * i_; \
            *(LAS u32x4*)((base_) + ((c_ >> 4) * 136 + 8 * (c_ & 15)) * 2) = kreg[i_]; } } while (0)
#ifdef PROBE_DSA_ATT2
        for (int rp_ = 0; rp_ < 2; ++rp_) { mrun = -1e30f; lsum = 0.f;
#pragma unroll
        for (int mb = 0; mb < 8; ++mb) O[mb] = (f32x4){0.f, 0.f, 0.f, 0.f};
#endif
        DSA_LOAD(0); DSA_STORE(lds + DS_BUF0);
        __syncthreads();
#pragma unroll 1
        for (int s = 0; s < NS; ++s) {
            LAS unsigned char* cb_ = lds + ((s & 1) ? DS_BUF1 : DS_BUF0); LAS unsigned char* nb_ = lds + ((s & 1) ? DS_BUF0 : DS_BUF1);
            if (s + 1 < NS) DSA_LOAD(s + 1);
            const LAS unsigned char* KT = cb_;
            f32x4 S[4];
#pragma unroll
            for (int T = 0; T < 4; ++T) { S[T] = (f32x4){0.f, 0.f, 0.f, 0.f}; Frag ak[4];
#pragma unroll
                for (int ks = 0; ks < 4; ++ks) ak[ks].q = *(const LAS u32x4*)(KT + ((16 * T + r) * 136 + 8 * qd + 32 * ks) * 2);
#pragma unroll
                for (int ks = 0; ks < 4; ++ks) S[T] = mfma16(ak[ks], bq[ks], S[T]); }
            const unsigned sw0 = SEL[qq * SP + 2 * s], sw1 = (2 * s + 1 < 128) ? SEL[qq * SP + 2 * s + 1] : 0u;
            const bool far = (p0 - (64 * s + 63)) >= 113;
            float l2[16]; float mx = -1e30f;
            f32x4 rsk[4];
#pragma unroll
            for (int T = 0; T < 4; ++T) rsk[T] = *(const LAS f32x4*)(RSK + 64 * s + 16 * T + 4 * qd);
            float bias[16];
#pragma unroll
            for (int e = 0; e < 16; ++e) bias[e] = bfar;
            if (!far) {
#pragma unroll
                for (int T = 0; T < 4; ++T)
#pragma unroll
                    for (int j = 0; j < 4; ++j) { int dist = pos - (64 * s + 16 * T + 4 * qd + j); dist = dist < 0 ? 0 : (dist > 127 ? 127 : dist); bias[4 * T + j] = LUT[dist * 4 + h]; } }
#pragma unroll
            for (int T = 0; T < 4; ++T) { const unsigned nib = (((T & 2) ? sw1 : sw0) >> (16 * (T & 1) + 4 * qd)) & 15u;
#pragma unroll
                for (int j = 0; j < 4; ++j) { const float v = (nib & (1u << j)) ? (S[T][j] * rsk[T][j] + bias[4 * T + j]) : -1e30f; l2[4 * T + j] = v; mx = fmaxf(mx, v); } }
            mx = fmaxf(mx, __shfl_xor(mx, 16)); mx = fmaxf(mx, __shfl_xor(mx, 32));
            const float mnew = fmaxf(mrun, mx), alpha = __builtin_amdgcn_exp2f(mrun - mnew); mrun = mnew;
            float ps = 0.f; Frag pb[2];
#pragma unroll
            for (int u = 0; u < 2; ++u) { float pv[8];
#pragma unroll
                for (int j = 0; j < 8; ++j) { const float v = l2[8 * u + j]; pv[j] = (v > -1e29f) ? __builtin_amdgcn_exp2f(v - mnew) : 0.f; ps += pv[j]; }
#pragma unroll
                for (int j = 0; j < 8; ++j) pv[j] *= rsk[2 * u + (j >> 2)][j & 3] * 0.69314718f;
                pb[u].u[0] = pk2(pv[0], pv[1]); pb[u].u[1] = pk2(pv[2], pv[3]); pb[u].u[2] = pk2(pv[4], pv[5]); pb[u].u[3] = pk2(pv[6], pv[7]); }
            lsum = lsum * alpha + ps;
            if (__any(alpha != 1.0f)) {
#pragma unroll
                for (int mb = 0; mb < 8; ++mb) O[mb] = O[mb] * alpha; }
#pragma unroll
            for (int mb = 0; mb < 8; ++mb)
#pragma unroll
                for (int u = 0; u < 2; ++u) { Frag a; const u32x2 t0 = lds_tr16(KT + ((32 * u + 4 * qd + (r >> 2)) * 136 + 16 * mb + 4 * (r & 3)) * 2), t1 = lds_tr16(KT + ((32 * u + 16 + 4 * qd + (r >> 2)) * 136 + 16 * mb + 4 * (r & 3)) * 2);
                    a.u[0] = t0.x; a.u[1] = t0.y; a.u[2] = t1.x; a.u[3] = t1.y; O[mb] = mfma16(a, pb[u], O[mb]); }
            if (s + 1 < NS) DSA_STORE(nb_);
            __syncthreads();
        }
#ifdef PROBE_DSA_ATT2
        }
#endif
#undef DSA_LOAD
#undef DSA_STORE
        lsum += __shfl_xor(lsum, 16); lsum += __shfl_xor(lsum, 32);
        const float inv = 1.0f / lsum;
#pragma unroll
        for (int mb = 0; mb < 8; ++mb) { u32x2 w; w.x = pk2(O[mb][0] * inv, O[mb][1] * inv); w.y = pk2(O[mb][2] * inv, O[mb][3] * inv);
            *(u32x2*)(olat + row * 512 + h * 128 + 16 * mb + 4 * qd) = w; }
    }
    __syncthreads();
}
__device__ __forceinline__ void dsa_worker(LAS unsigned char* lds, int tid, int lq) {
    const int l = lq & 1;
    unsigned* ctl = (unsigned*)(wsp() + WS_CTL);
    const unsigned myx = xb_xcc_id() & 7u;
    LAS unsigned* ITEM = (LAS unsigned*)(lds + DS_ITEM);
#pragma unroll 1
    for (unsigned qs = 0; qs < 8; ++qs) { const unsigned bq = (myx + qs) & 7u;
#pragma unroll 1
        for (;;) {
            if (tid == 0) ITEM[0] = __hip_atomic_fetch_add(ctl + CW_QUEUE + (lq * 8 + (int)bq) * 64, 1u, __ATOMIC_RELAXED, __HIP_MEMORY_SCOPE_AGENT);
            __syncthreads();
            const unsigned id = ITEM[0];
            __syncthreads();
            if (id >= 128u) break;
            dsa_process_item(lds, tid, l, (int)bq, 127 - (int)id);
        }
    }
}

#ifndef MIX_DSA_OPT
#define MIX_DSA_OPT 1
#endif
#ifndef MIX_CHAINS
#define MIX_CHAINS 7
#endif
__device__ __forceinline__ void naive_gla(Frame& F, int l, int mixer, int b, int h) {
    LAS float* Q = (LAS float*)F.lds; LAS float* K = Q + 4096; LAS float* V = K + 4096; LAS float* Bc = V + 4096; LAS float* S = Bc + 4096; LAS float* AT = S + 4096; LAS float* QE = AT + 4096; LAS float* KT = QE + 4096;
    const int tid = F.tid;
    const bf16* a16 = (const bf16*)(wsp() + WS_A16); const float* a32 = (const float*)(wsp() + WS_A32);
    bf16* Y = (bf16*)(wsp() + (mixer == 0 ? WS_YB : WS_YD));
    const float* gn = inp(mixer == 0 ? IN_GLAG : IN_HGRNG) + l * 64;
    const float* wgk2 = inp(IN_WGK2) + (size_t)l * 16 * 256; const float* bgk = inp(IN_BGK) + l * 256;
    for (int i = 0; i < 8; ++i) S[tid + 512 * i] = 0.f;
    __syncthreads();
    for (int c = 0; c < 64; ++c) {
        const int t0 = b * SEQ + c * 64;
#pragma unroll 1
        for (int i = 0; i < 8; ++i) { const int e = tid + 512 * i, tt = e >> 6, d = e & 63; const size_t row = (size_t)(t0 + tt);
            float q, k, v, g;
            if (mixer == 0) {
                q = bf2f(a16[row * A16_LD + C_BQ + h * 64 + d]); k = bf2f(a16[row * A16_LD + C_BK + h * 64 + d]); v = bf2f(a16[row * A16_LD + C_BV + h * 64 + d]);
                float z = bgk[h * 64 + d];
#pragma unroll 4
                for (int r = 0; r < 16; ++r) z += a32[row * A32_LD + C_LR + r] * wgk2[r * 256 + h * 64 + d];
                g = (fminf(z, 0.f) - log1pf(expf(-fabsf(z)))) * (1.0f / 16.0f);
            } else {
                q = bf2f(a16[row * A16_LD + C_DQ + h * 64 + d]); const float lf = bf2f(a16[row * A16_LD + C_DF + h * 64 + d]); k = -expm1f(lf); v = bf2f(a16[row * A16_LD + C_DI + h * 64 + d]); g = lf;
            }
            Q[e] = q; K[e] = k; V[e] = v; Bc[e] = g; }
        __syncthreads();
        if (tid < 64) { float run = 0.f; for (int tt = 0; tt < 64; ++tt) { run += Bc[tt * 64 + tid]; Bc[tt * 64 + tid] = run; } }
        __syncthreads();
#pragma unroll 1
        for (int i = 0; i < 8; ++i) { const int e = tid + 512 * i, ii = e >> 6, jj = e & 63; float a = 0.f;
            if (jj <= ii) for (int d = 0; d < 64; ++d) a += Q[ii * 64 + d] * K[jj * 64 + d] * __expf(Bc[ii * 64 + d] - Bc[jj * 64 + d]);
            AT[e] = a;
            const int d2 = e & 63, t2 = e >> 6; QE[e] = Q[e] * __expf(Bc[e]); KT[e] = K[e] * __expf(Bc[63 * 64 + d2] - Bc[t2 * 64 + d2]); }
        __syncthreads();
#pragma unroll 1
        for (int i = 0; i < 8; ++i) { const int e = tid + 512 * i, ii = e >> 6, vv = e & 63; float a = 0.f;
#pragma unroll 2
            for (int j = 0; j <= ii; ++j) a += AT[ii * 64 + j] * V[j * 64 + vv];
#pragma unroll 2
            for (int d = 0; d < 64; ++d) a += QE[ii * 64 + d] * S[d * 64 + vv];
            asm volatile("s_waitcnt lgkmcnt(0)" ::: "memory");
            AT[e] = a; }
        __syncthreads();
#pragma unroll 1
        for (int i = 0; i < 8; ++i) { const int e = tid + 512 * i, d = e >> 6, vv = e & 63;
            float a = __expf(Bc[63 * 64 + d]) * S[e];
#pragma unroll 2
            for (int j = 0; j < 64; ++j) a += KT[j * 64 + d] * V[j * 64 + vv];
            S[e] = a; }
        __syncthreads();
#pragma unroll 1
        for (int i = 0; i < 8; ++i) { const int e = tid + 512 * i, ii = e >> 6, vv = e & 63; float ss = 0.f;
            for (int v2 = 0; v2 < 64; ++v2) ss += AT[ii * 64 + v2] * AT[ii * 64 + v2];
            const float rs = 1.0f / sqrtf(ss * (1.0f / 64.f) + EPS); const size_t row = (size_t)(t0 + ii);
            const float gate = bf2f(a16[row * A16_LD + (mixer == 0 ? C_BR : C_DG) + h * 64 + vv]);
            Y[row * 256 + h * 64 + vv] = (bf16)f2bf(AT[e] * rs * gn[vv] * gate); }
        __syncthreads();
    }
}
__device__ __forceinline__ void naive_rglru(Frame& F, int l, int b, int blk) {
    LAS float* XC = (LAS float*)F.lds; LAS float* AA = XC + 4096; LAS float* UU = AA + 4096; LAS float* HH = UU + 4096;
    const int tid = F.tid;
    const bf16* a16 = (const bf16*)(wsp() + WS_A16); const float* a32 = (const float*)(wsp() + WS_A32); bf16* Y = (bf16*)(wsp() + WS_YC);
    const float* cw = inp(IN_CONVW) + l * 4 * 256; const float* cb = inp(IN_CONVB) + l * 256;
    const float* wa = inp(IN_WRGA) + ((size_t)l * 4 + blk) * 4096; const float* ba = inp(IN_BRGA) + l * 256 + blk * 64;
    const float* wx = inp(IN_WRGX) + ((size_t)l * 4 + blk) * 4096; const float* bx = inp(IN_BRGX) + l * 256 + blk * 64;
    const float* lam = inp(IN_LAM) + l * 256 + blk * 64;
    float hcur = 0.f;
    for (int c = 0; c < 64; ++c) {
        const int t0 = c * 64;
#pragma unroll 1
        for (int i = 0; i < 8; ++i) { const int e = tid + 512 * i, tt = e >> 6, ch = e & 63, t = t0 + tt, gc = blk * 64 + ch; float a = cb[gc];
            for (int j = 0; j < 4; ++j) { const int ts = t - 3 + j; if (ts >= 0) a += cw[j * 256 + gc] * bf2f(a16[(size_t)(b * SEQ + ts) * A16_LD + C_CX + gc]); }
            XC[e] = a; }
        __syncthreads();
#pragma unroll 1
        for (int i = 0; i < 8; ++i) { const int e = tid + 512 * i, tt = e >> 6, j = e & 63; float za = ba[j], zx = bx[j];
#pragma unroll 4
            for (int k = 0; k < 64; ++k) { const float x = XC[tt * 64 + k]; za += x * wa[k * 64 + j]; zx += x * wx[k * 64 + j]; }
            const float r = 1.0f / (1.0f + expf(-za)), ig = 1.0f / (1.0f + expf(-zx));
            const float nl = -lam[j]; const float sp = fmaxf(nl, 0.f) + log1pf(expf(-fabsf(nl)));
            const float la = -8.0f * r * sp;
            AA[e] = expf(la); UU[e] = sqrtf(fmaxf(-expm1f(2.0f * la), 0.f)) * (ig * XC[e]); }
        __syncthreads();
        if (tid < 64) { for (int tt = 0; tt < 64; ++tt) { hcur = AA[tt * 64 + tid] * hcur + UU[tt * 64 + tid]; HH[tt * 64 + tid] = hcur; } }
        __syncthreads();
#pragma unroll 1
        for (int i = 0; i < 8; ++i) { const int e = tid + 512 * i, tt = e >> 6, ch = e & 63; const size_t row = (size_t)(b * SEQ + t0 + tt);
            Y[row * 256 + blk * 64 + ch] = (bf16)f2bf(HH[e] * bf2f(a16[row * A16_LD + C_CY + blk * 64 + ch])); }
        __syncthreads();
    }
}
__device__ __forceinline__ void naive_dsa(Frame& F, int l, int wg, int nwg) {
    LAS unsigned short* KEYS = (LAS unsigned short*)F.lds;
    LAS unsigned char* wbase = F.lds + 65536 + F.wave * 8192;
    LAS float* IQs = (LAS float*)wbase;
    LAS float* QLs = IQs + 256;
    LAS unsigned short* IDX = (LAS unsigned short*)(QLs + 512);
    LAS float* Ps = (LAS float*)(wbase + 3584);
    LAS unsigned short* myk = KEYS + F.wave * 4096;
    const int lane = F.lane;
    const bf16* a16 = (const bf16*)(wsp() + WS_A16); const float* a32 = (const float*)(wsp() + WS_A32);
    const bf16* ckv = (const bf16*)(wsp() + WS_CKV); const bf16* ikb = (const bf16*)(wsp() + WS_IK); bf16* olat = (bf16*)(wsp() + WS_OLAT);
    const float* relb = inp(IN_RELB);
    for (int it = wg; it < M / 8; it += nwg) {
        const int row = it * 8 + F.wave, b = row / SEQ, pos = row % SEQ, n = pos + 1;
        const size_t brow = (size_t)b * SEQ;
        for (int i = lane; i < 256; i += 64) IQs[i] = bf2f(a16[(size_t)row * A16_LD + C_IQ + i]);
        for (int i = lane; i < 512; i += 64) QLs[i] = bf2f(a16[(size_t)row * A16_LD + C_QL + i]);
        const float w0 = a32[(size_t)row * A32_LD + C_IW + 0], w1 = a32[(size_t)row * A32_LD + C_IW + 1], w2 = a32[(size_t)row * A32_LD + C_IW + 2], w3 = a32[(size_t)row * A32_LD + C_IW + 3];
        asm volatile("s_waitcnt lgkmcnt(0)" ::: "memory");
#pragma unroll 1
        for (int s0 = 0; s0 < n; s0 += 64) { const int s = s0 + lane;
            if (s < n) { const u32x4* kr = (const u32x4*)(ikb + (brow + s) * 64); float d0 = 0.f, d1 = 0.f, d2 = 0.f, d3 = 0.f;
#pragma unroll 2
                for (int c8 = 0; c8 < 8; ++c8) { const u32x4 kw = kr[c8]; const unsigned kk[4] = {kw.x, kw.y, kw.z, kw.w};
#pragma unroll
                    for (int j = 0; j < 4; ++j) { const float k0 = bflo(kk[j]), k1 = bfhi(kk[j]); const int d = c8 * 8 + 2 * j;
                        d0 += IQs[d] * k0 + IQs[d + 1] * k1; d1 += IQs[64 + d] * k0 + IQs[64 + d + 1] * k1; d2 += IQs[128 + d] * k0 + IQs[128 + d + 1] * k1; d3 += IQs[192 + d] * k0 + IQs[192 + d + 1] * k1; } }
                const float sc = w0 * fmaxf(d0, 0.f) + w1 * fmaxf(d1, 0.f) + w2 * fmaxf(d2, 0.f) + w3 * fmaxf(d3, 0.f);
                myk[s] = (unsigned short)key16(sc); } }
        asm volatile("s_waitcnt lgkmcnt(0)" ::: "memory");
        unsigned tau = 0; int r = 0;
        if (n > TOPK) {
            for (int bit = 15; bit >= 0; --bit) { const unsigned cand = tau | (1u << bit); int cnt = 0;
                for (int s = lane; s < n; s += 64) cnt += ((unsigned)myk[s] >= cand) ? 1 : 0;
                cnt = wave_isum(cnt); if (cnt >= TOPK) tau = cand; }
            int cg = 0; for (int s = lane; s < n; s += 64) cg += ((unsigned)myk[s] > tau) ? 1 : 0;
            cg = wave_isum(cg); r = TOPK - cg;
        }
        int nsel = 0, ties = 0;
        for (int s0 = 0; s0 < n; s0 += 64) { const int s = s0 + lane; bool gt = false, tie = false;
            if (s < n) { if (n <= TOPK) gt = true; else { const unsigned k = myk[s]; gt = k > tau; tie = (k == tau); } }
            const unsigned long long tb = __ballot(tie); const unsigned long long lt = (1ull << lane) - 1ull;
            const int trank = ties + __popcll(tb & lt); const bool sel = gt || (tie && trank < r);
            const unsigned long long sb = __ballot(sel); const int p = nsel + __popcll(sb & lt);
            if (sel) IDX[p] = (unsigned short)s;
            nsel += __popcll(sb); ties += __popcll(tb); }
        asm volatile("s_waitcnt lgkmcnt(0)" ::: "memory");
        float lg[4][4];
#pragma unroll
        for (int j = 0; j < 4; ++j) { const int kx = j * 64 + lane;
            if (kx < nsel) { const int s = IDX[kx]; const u32x4* cr = (const u32x4*)(ckv + (brow + s) * 128); float d0 = 0.f, d1 = 0.f, d2 = 0.f, d3 = 0.f;
#pragma unroll 2
                for (int c8 = 0; c8 < 16; ++c8) { const u32x4 cw = cr[c8]; const unsigned cc[4] = {cw.x, cw.y, cw.z, cw.w};
#pragma unroll
                    for (int q = 0; q < 4; ++q) { const float c0 = bflo(cc[q]), c1 = bfhi(cc[q]); const int d = c8 * 8 + 2 * q;
                        d0 += QLs[d] * c0 + QLs[d + 1] * c1; d1 += QLs[128 + d] * c0 + QLs[128 + d + 1] * c1; d2 += QLs[256 + d] * c0 + QLs[256 + d + 1] * c1; d3 += QLs[384 + d] * c0 + QLs[384 + d + 1] * c1; } }
                const int bk = t5_bucket(pos - s);
                lg[j][0] = d0 + relb[bk * 4 + 0]; lg[j][1] = d1 + relb[bk * 4 + 1]; lg[j][2] = d2 + relb[bk * 4 + 2]; lg[j][3] = d3 + relb[bk * 4 + 3];
            } else { lg[j][0] = lg[j][1] = lg[j][2] = lg[j][3] = -1e30f; } }
#pragma unroll
        for (int hh = 0; hh < 4; ++hh) { float mx = fmaxf(fmaxf(lg[0][hh], lg[1][hh]), fmaxf(lg[2][hh], lg[3][hh])); mx = wave_max(mx);
            float e[4], sm = 0.f;
#pragma unroll
            for (int j = 0; j < 4; ++j) { e[j] = (j * 64 + lane < nsel) ? __expf(lg[j][hh] - mx) : 0.f; sm += e[j]; }
            sm = wave_sum(sm); const float inv = 1.0f / sm;
#pragma unroll
            for (int j = 0; j < 4; ++j) Ps[hh * 256 + j * 64 + lane] = e[j] * inv; }
        asm volatile("s_waitcnt lgkmcnt(0)" ::: "memory");
        float o[4][2] = {{0.f, 0.f}, {0.f, 0.f}, {0.f, 0.f}, {0.f, 0.f}};
#pragma unroll 2
        for (int kx = 0; kx < nsel; ++kx) { const int s = IDX[kx]; const unsigned cw = *(const unsigned*)(ckv + (brow + s) * 128 + 2 * lane); const float c0 = bflo(cw), c1 = bfhi(cw);
#pragma unroll
            for (int hh = 0; hh < 4; ++hh) { const float p = Ps[hh * 256 + kx]; o[hh][0] += p * c0; o[hh][1] += p * c1; } }
#pragma unroll
        for (int hh = 0; hh < 4; ++hh) *(unsigned*)(olat + (size_t)row * 512 + hh * 128 + 2 * lane) = pk2(o[hh][0], o[hh][1]);
        asm volatile("s_waitcnt lgkmcnt(0)" ::: "memory");
    }
}
__device__ __forceinline__ void phase_mixers_naive(Frame& F, int l, int rep) {
    const int wg = (int)blockIdx.x;
#ifdef PROBE_CHAINS2
    for (int rp_ = 0; rp_ < PROBE_CHAINS2; ++rp_)
#endif
    if (wg < 32) { if (MIX_CHAINS & 1) gla_chain(F.lds, F.tid, l, 0, wg >> 2, wg & 3); else naive_gla(F, l, 0, wg >> 2, wg & 3); }
    else if (wg < 64) { if (MIX_CHAINS & 2) gla_chain(F.lds, F.tid, l, 1, (wg - 32) >> 2, (wg - 32) & 3); else naive_gla(F, l, 1, (wg - 32) >> 2, (wg - 32) & 3); }
    else if (wg < 96) { if (MIX_CHAINS & 4) rglru_chain(F.lds, F.tid, l, (wg - 64) >> 2, (wg - 64) & 3); else naive_rglru(F, l, (wg - 64) >> 2, (wg - 64) & 3); }
#if MIX_DSA_OPT
#ifdef PROBE_REP_CHAINS_ONLY
    if (rep == 0)
#endif
    dsa_worker(F.lds, F.tid, l + 2 * rep);
#else
    else { naive_dsa(F, l, wg - 96, F.G - 96); }
#endif
}
__device__ __forceinline__ void phase_final(Frame& F) {
    const int gw = F.vcu * NWAVES + F.wave, NGW = F.G * NWAVES, lane = F.lane;
    const rss_t* rss = (const rss_t*)(wsp() + WS_RSS) + 4 * (size_t)M; const f32x4* g = (const f32x4*)inp(IN_FNORM) + lane;
    float* outb = outp(); const bf16* xb = (const bf16*)(wsp() + WS_XB);
    for (int m = gw; m < M; m += 4 * NGW) {
        u32x2 v[4][4]; float rsv[4];
#pragma unroll
        for (int u = 0; u < 4; ++u) { rsv[u] = rss_dec(rss[m + u * NGW]); const u32x2* xr = (const u32x2*)(xb + (size_t)(m + u * NGW) * DM) + lane;
#pragma unroll
            for (int j = 0; j < 4; ++j) v[u][j] = xr[64 * j]; }
#pragma unroll
        for (int u = 0; u < 4; ++u) { const float rs = 1.0f / sqrtf(rsv[u] * (1.0f / DM) + EPS); f32x4* xr = (f32x4*)(outb + (size_t)(m + u * NGW) * DM) + lane;
#pragma unroll
            for (int j = 0; j < 4; ++j) { const u32x2 w = v[u][j]; xr[64 * j] = (f32x4){bflo(w.x), bfhi(w.x), bflo(w.y), bfhi(w.y)} * rs * g[64 * j]; } } }
}

#ifndef STAGGER_TICKS
#define STAGGER_TICKS 0
#endif
#ifndef STAGGER_GM
#define STAGGER_GM 3u
#endif
#ifndef STAGGER_SLEEP
#define STAGGER_SLEEP 127
#endif
#define STAGGER() do { if (STAGGER_TICKS) { const unsigned grp_ = (unsigned)__builtin_amdgcn_readfirstlane((int)((blockIdx.x >> 3) & STAGGER_GM)); for (unsigned i_ = 0; i_ < grp_ * (STAGGER_TICKS); ++i_) __builtin_amdgcn_s_sleep(STAGGER_SLEEP); } } while (0)
#ifndef GEMM_SP2
#define GEMM_SP2 true
#endif
#ifndef RELAX_MASK
#define RELAX_MASK 0x00u
#endif
#define RLX(b) (((RELAX_MASK >> (b)) & 1u) != 0u)
#ifndef GEMM_ALIGN_EPI
#define GEMM_ALIGN_EPI true
#endif
#ifndef MK_ONE_LAUNCH
#define MK_ONE_LAUNCH 1
#endif
constexpr int PH_PER_LAYER = 8;
constexpr int N_PHASES = 1 + DEPTH * PH_PER_LAYER + 1;
struct Args { const float* in[30]; float* out; unsigned char* ws; int ph_lo, ph_hi; };
__device__ __forceinline__ int fresh_lane_id() { unsigned ones = ~0u; asm volatile("" : "+s"(ones)); return (int)__builtin_amdgcn_mbcnt_hi(ones, __builtin_amdgcn_mbcnt_lo(ones, 0u)); }
__global__ void __launch_bounds__(NWAVES * 64, 2) hybrid_fwd(Args args) {
    extern __shared__ __attribute__((aligned(16))) unsigned char lds[];
    const int wave_s_ = __builtin_amdgcn_readfirstlane((int)threadIdx.x >> 6);
#define MYTID() (wave_s_ * 64 + fresh_lane_id())
#define MKFRAME Frame F; { int t_ = MYTID(); asm volatile("" : "+v"(t_)); F.lds = (LAS unsigned char*)lds; F.tid = t_; F.lane = t_ & 63; F.wave = __builtin_amdgcn_readfirstlane(t_ >> 6); F.G = gridDim.x; const int bx = blockIdx.x; F.vcu = (F.G % 8 == 0) ? (bx % 8) * (F.G / 8) + bx / 8 : bx; }
    for (int u = threadIdx.x; u < (LDS_BYTES - LDSCTL_OFF) / 4; u += NWAVES * 64) ((LAS unsigned*)((LAS unsigned char*)lds + LDSCTL_OFF))[u] = 0u;
    __syncthreads();
    if (MK_ONE_LAUNCH) (void)xcd_barrier_post((unsigned*)(wsp() + WS_CTL) + CW_BAR, (volatile LAS unsigned*)((LAS unsigned char*)lds + MISC_OFF) + 8);
    const int lo = args.ph_lo, hi = args.ph_hi; (void)lo; (void)hi;
#ifndef PH_MASK
#define PH_MASK 0xFFFFFFFFu
#endif
#if MK_ONE_LAUNCH
#define IN(k) true
#else
#define IN(k) (lo <= (k) && (k) < hi)
#endif
#define EN(b) ((PH_MASK >> (b)) & 1u)
#ifndef REP_MASK
#define REP_MASK 0u
#endif
#define REPS(b) for (int rep_ = 0; rep_ < (int)((REP_MASK >> (b)) & 1u) + 1; ++rep_)
#define SEAM(k) do { if (IN(k) && IN((k) + 1)) { XcdBarrier bar_; bar_.bar = (unsigned*)(wsp() + WS_CTL) + CW_BAR; bar_.x = xb_xcc_id(); bar_.st = (volatile LAS unsigned*)((LAS unsigned char*)lds + MISC_OFF) + 8; xcd_barrier(bar_, wave_s_ == 0 && fresh_lane_id() == 0); } } while (0)
    if (EN(0) && IN(0)) REPS(0) { MKFRAME phase_prologue(F); } SEAM(0);
    for (int l = 0; l < DEPTH; ++l) {
        const int p0 = 1 + l * PH_PER_LAYER;
#define PH_PTRS int gx_ = (int)gridDim.x, bx_ = (int)blockIdx.x; asm volatile("" : "+s"(gx_), "+s"(bx_)); unsigned char* ws = wsp(); unsigned char* wb = ws + WS_W + (size_t)l * W_LAYER; rss_t* rssb = (rss_t*)(ws + WS_RSS); bf16* xb = (bf16*)(ws + WS_XB); (void)wb; (void)rssb; (void)xb;
        if (EN(1) && IN(p0 + 0)) REPS(1) {
            PH_PTRS
            STAGGER();
            pg8::Gemm g{(const pg8::bf16_t*)xb, (const pg8::bf16_t*)(wb + W_IN), M, NIN, DM}; pg8::StaticOrder S; S.init(M, NIN, gx_, bx_);
            LAS float* lbl = (LAS float*)((LAS unsigned char*)lds + LDSCTL_OFF + 1024);
            { const float* tab = (const float*)(ws + WS_TAB); const int t_ = MYTID(); if (t_ < 256) { lbl[t_] = tab[l * 256 + t_]; lbl[256 + t_] = tab[512 + l * 256 + t_]; } }
            __syncthreads();
            EpiInProj E{(bf16*)(ws + WS_A16), (float*)(ws + WS_A32), rssb + (size_t)(2 * l) * M, lbl, lbl + 256, (bf16*)(ws + WS_CKV), (bf16*)(ws + WS_IK), (rss_t*)(ws + WS_CKSS) + (size_t)l * M};
            pg8::gemm_phase<EpiInProj, pg8::StaticOrder, GEMM_ALIGN_EPI, GEMM_SP2, RLX(0)>((PG8_LAS unsigned char*)lds, g, S, E, MYTID());
        } SEAM(p0 + 0);
        if (EN(3) && IN(p0 + 2)) REPS(3) { MKFRAME phase_mixers_naive(F, l, rep_); } SEAM(p0 + 2);
        if (EN(4) && IN(p0 + 3)) REPS(4) {
            STAGGER();
            for (int br = 0; br < 2; ++br) {
                PH_PTRS
                pg8::Gemm g{(const pg8::bf16_t*)(ws + (br ? WS_YB : WS_OLAT)), (const pg8::bf16_t*)(wb + (br ? W_BRB : W_BRA)), M, DM, br ? 256 : 512}; StackOrder S; S.init(gx_, bx_, br ? 3 : 1); EpiBf16Plain E{(bf16*)(ws + WS_P), 4096, 0, br};
                pg8::gemm_phase<EpiBf16Plain, StackOrder, GEMM_ALIGN_EPI, GEMM_SP2, RLX(1)>((PG8_LAS unsigned char*)lds, g, S, E, MYTID());
            }
        } SEAM(p0 + 3);
        if (EN(5) && IN(p0 + 4)) REPS(5) {
            PH_PTRS
            STAGGER();
            pg8::Gemm g{(const pg8::bf16_t*)xb, (const pg8::bf16_t*)(wb + W_GATE), M, 4096, DM}; pg8::StaticOrder S; S.init(M, 4096, gx_, bx_);
            LAS bf16* bl = (LAS bf16*)((LAS unsigned char*)lds + LDSCTL_OFF + 1024);
            { const float* bg = inp(IN_BGATE) + l * 4096; for (int i = MYTID(); i < 4096; i += NWAVES * 64) bl[i] = (bf16)f2bf(bg[i]); }
            __syncthreads();
            EpiGateMerge E{(const bf16*)(ws + WS_P), (bf16*)(ws + WS_MRG), rssb + (size_t)(2 * l) * M, bl};
            pg8::gemm_phase<EpiGateMerge, pg8::StaticOrder, GEMM_ALIGN_EPI, GEMM_SP2, RLX(2)>((PG8_LAS unsigned char*)lds, g, S, E, MYTID());
        } SEAM(p0 + 4);
        if (EN(6) && IN(p0 + 5)) {
            PH_PTRS
            pg8::Gemm g{(const pg8::bf16_t*)(ws + WS_MRG), (const pg8::bf16_t*)(wb + W_OUT), M, DM, DM, 1}; pg8::StaticOrder S; S.init(M, DM, gx_, bx_);
            EpiResid E{xb, rssb + (size_t)(2 * l + 1) * M};
            pg8::gemm_phase<EpiResid, pg8::StaticOrder, GEMM_ALIGN_EPI, GEMM_SP2, RLX(3)>((PG8_LAS unsigned char*)lds, g, S, E, MYTID());
        } SEAM(p0 + 5);
        if (EN(7) && IN(p0 + 6)) REPS(7) {
            PH_PTRS
            STAGGER();
            pg8::Gemm g{(const pg8::bf16_t*)xb, (const pg8::bf16_t*)(wb + W_FF1), M, DFF, DM}; pg8::StaticOrder S; S.init(M, DFF, gx_, bx_);
#ifdef PROBE_KLOOP
            { EpiNull EN_{(float*)(ws + WS_CTL) + 2048}; pg8::gemm_phase<EpiNull, pg8::StaticOrder, GEMM_ALIGN_EPI, GEMM_SP2, GEMM_RELAX>((PG8_LAS unsigned char*)lds, g, S, EN_, MYTID()); }
#endif
            EpiFF1 E{(bf16*)(ws + WS_HID), rssb + (size_t)(2 * l + 1) * M};
            pg8::gemm_phase<EpiFF1, pg8::StaticOrder, GEMM_ALIGN_EPI, GEMM_SP2, RLX(4)>((PG8_LAS unsigned char*)lds, g, S, E, MYTID());
        } SEAM(p0 + 6);
        if (EN(8) && IN(p0 + 7)) {
            PH_PTRS
            pg8::Gemm g{(const pg8::bf16_t*)(ws + WS_HID), (const pg8::bf16_t*)(wb + W_FF2), M, DM, DFF, 1}; pg8::StaticOrder S; S.init(M, DM, gx_, bx_);
            EpiResid E{xb, rssb + (size_t)(2 * l + 2) * M};
            pg8::gemm_phase<EpiResid, pg8::StaticOrder, GEMM_ALIGN_EPI, GEMM_SP2, RLX(3)>((PG8_LAS unsigned char*)lds, g, S, E, MYTID());
        } SEAM(p0 + 7);
    }
    if (EN(9) && IN(N_PHASES - 1)) { MKFRAME phase_final(F); }
#undef IN
#undef SEAM
}

extern "C" void kernel_launch(void* const* d_in, const int* in_sizes, int n_in, void* d_out, int out_size, void* d_ws, size_t ws_size, hipStream_t stream) {
    static int grid = 0;
    if (grid == 0) {
        if (n_in != 30 || in_sizes[0] != M * DM || out_size != M * DM || ws_size < WS_END) { fprintf(stderr, "kernel_launch: unexpected problem (n_in %d, in0 %d, out %d, ws %zu)\n", n_in, n_in > 0 ? in_sizes[0] : -1, out_size, ws_size); grid = -1; return; }
        int dev = 0, cus = 0, per_cu = 0;
        if (hipGetDevice(&dev) != hipSuccess || hipDeviceGetAttribute(&cus, hipDeviceAttributeMultiprocessorCount, dev) != hipSuccess) { grid = -1; return; }
        if (hipFuncSetAttribute((const void*)hybrid_fwd, hipFuncAttributeMaxDynamicSharedMemorySize, LDS_BYTES) != hipSuccess) { fprintf(stderr, "kernel_launch: hipFuncSetAttribute failed\n"); grid = -1; return; }
        if (hipOccupancyMaxActiveBlocksPerMultiprocessor(&per_cu, (const void*)hybrid_fwd, NWAVES * 64, LDS_BYTES) != hipSuccess || per_cu < 1) fprintf(stderr, "kernel_launch: occupancy query reports %d\n", per_cu);
        (void)hipGetLastError();
        grid = cus;
    }
    if (grid < 0) return;
    if (hipMemsetAsync((char*)d_ws + WS_CTL, 0, CTL_ZERO_BYTES, stream) != hipSuccess) return;
    Args a{};
    for (int i = 0; i < 30; ++i) a.in[i] = (const float*)d_in[i];
    a.out = (float*)d_out; a.ws = (unsigned char*)d_ws;
#if MK_ONE_LAUNCH
    a.ph_lo = 0; a.ph_hi = N_PHASES;
    hipLaunchKernelGGL(hybrid_fwd, dim3(grid), dim3(NWAVES * 64), LDS_BYTES, stream, a);
#else
    for (int p = 0; p < N_PHASES; ++p) { a.ph_lo = p; a.ph_hi = p + 1; hipLaunchKernelGGL(hybrid_fwd, dim3(grid), dim3(NWAVES * 64), LDS_BYTES, stream, a); }
#endif
}
```
